# Optimizing an MI355X kernel written in HIP

```python
import math
import jax
import jax.numpy as jnp
from jax import lax
import numpy as np

D_MODEL = 1024
BATCH = 4
SEQ = 4096
DEPTH = 2
DEC_BATCH = 128
DEC_SEQ = 4
PAST_LEN = 16384
PAGE_SIZE = 128

BRANCH_W = D_MODEL // 2
N_BRANCH = 3
HEAD_DIM = 64
N_HEADS = BRANCH_W // HEAD_DIM
N_KV_HEADS = 2
KV_GROUP = N_HEADS // N_KV_HEADS
WINDOW = 128
ROPE_THETA = 10000.0
SSM_W = BRANCH_W
SSM_GROUP_CH = 16
SSM_GROUPS = SSM_W // SSM_GROUP_CH
SSM_STATE = 64
N_MEM = 256
MEM_HEADS = 4
MEM_HEAD_DIM = BRANCH_W // MEM_HEADS
MEM_W = MEM_HEADS * MEM_HEAD_DIM
D_FF = -(-8 * D_MODEL // (3 * 256)) * 256
RMS_EPS = 1e-6

Q_OFF = 0
K_OFF = Q_OFF + N_HEADS * HEAD_DIM
V_OFF = K_OFF + N_KV_HEADS * HEAD_DIM
U_OFF = V_OFF + N_KV_HEADS * HEAD_DIM
MQ_OFF = U_OFF + SSM_W
G_OFF = MQ_OFF + MEM_W
IN_W = G_OFF + N_BRANCH * D_MODEL

kernel_name = 'hybrid_swa_s5_memxattn_decode_step'


def rms_norm(x, g):
    xf = x.astype(jnp.float32)
    xf = xf * lax.rsqrt(jnp.mean(xf * xf, axis=-1, keepdims=True) + RMS_EPS)
    return xf.astype(x.dtype) * g


def rotary(x, pos):
    half = x.shape[-1] // 2
    inv = ROPE_THETA ** (-jnp.arange(half, dtype=jnp.float32) / half)
    ang = pos[:, None] * inv[None, :]
    cos = jnp.cos(ang)[:, None, :]
    sin = jnp.sin(ang)[:, None, :]
    xf = x.astype(jnp.float32)
    x1, x2 = xf[..., :half], xf[..., half:]
    return jnp.concatenate([x1 * cos - x2 * sin, x2 * cos + x1 * sin], axis=-1).astype(x.dtype)


def sink_attention(q, k, v, mask, sinks):
    scale = 1.0 / math.sqrt(q.shape[-1])
    s = jnp.einsum('...qhgd,...khd->...hgqk', q.astype(jnp.float32), k.astype(jnp.float32)) * scale
    s = jnp.where(mask[..., None, None, :, :], s, -jnp.inf)
    sink = sinks.astype(jnp.float32)[:, :, None, None]
    m = jnp.maximum(jnp.max(s, axis=-1, keepdims=True), sink)
    p = jnp.exp(s - m)
    denom = jnp.sum(p, axis=-1, keepdims=True) + jnp.exp(sink - m)
    o = jnp.einsum('...hgqk,...khd->...qhgd', p / denom, v.astype(jnp.float32))
    return o.astype(q.dtype)


def swa_prompt(q, k, v, sinks):
    b, s = q.shape[0], q.shape[1]
    nb = s // WINDOW
    qb = q.reshape(b, nb, WINDOW, N_KV_HEADS, KV_GROUP, HEAD_DIM)

    def band(t):
        tb = t.reshape(b, nb, WINDOW, N_KV_HEADS, HEAD_DIM)
        prev = jnp.pad(tb, ((0, 0), (1, 0), (0, 0), (0, 0), (0, 0)))[:, :-1]
        return jnp.concatenate([prev, tb], axis=2)

    blk = jnp.arange(nb)[:, None] * WINDOW
    qpos = blk + jnp.arange(WINDOW)[None, :]
    kpos = blk - WINDOW + jnp.arange(2 * WINDOW)[None, :]
    diff = qpos[:, :, None] - kpos[:, None, :]
    mask = (diff >= 0) & (diff < WINDOW) & (kpos[:, None, :] >= 0)
    o = sink_attention(qb, band(k), band(v), mask, sinks.reshape(N_KV_HEADS, KV_GROUP))
    return o.reshape(b, s, BRANCH_W)


def swa_sample(q, k, v, past_k, past_v, sinks):
    b, t = q.shape[0], q.shape[1]
    kcat = jnp.concatenate([past_k.astype(k.dtype), k], axis=1)
    vcat = jnp.concatenate([past_v.astype(v.dtype), v], axis=1)
    kpos = jnp.concatenate([PAST_LEN - WINDOW + jnp.arange(WINDOW), PAST_LEN + jnp.arange(t)])
    qpos = PAST_LEN + jnp.arange(t)
    diff = qpos[:, None] - kpos[None, :]
    mask = ((diff >= 0) & (diff < WINDOW) & (kpos[None, :] >= 0))[None]
    qg = q.reshape(b, t, N_KV_HEADS, KV_GROUP, HEAD_DIM)
    o = sink_attention(qg, kcat, vcat, mask, sinks.reshape(N_KV_HEADS, KV_GROUP))
    return o.reshape(b, t, BRANCH_W), kcat[:, -WINDOW:], vcat[:, -WINDOW:]


def ssm_branch(u, h0_re, h0_im, p):
    b, t = u.shape[0], u.shape[1]
    f32 = jnp.float32
    ug = u.astype(f32).reshape(b, t, SSM_GROUPS, SSM_GROUP_CH)
    a_re = p['ssm_a_re'].astype(f32)
    a_im = p['ssm_a_im'].astype(f32)
    dt = jnp.exp(p['ssm_log_dt'].astype(f32))[:, None]
    mag = jnp.exp(a_re * dt)
    lam_re = mag * jnp.cos(a_im * dt)
    lam_im = mag * jnp.sin(a_im * dt)
    den = a_re * a_re + a_im * a_im
    nr, ni = lam_re - 1.0, lam_im
    g_re = (nr * a_re + ni * a_im) / den
    g_im = (ni * a_re - nr * a_im) / den
    bu_re = jnp.einsum('btgc,gpc->btgp', ug, p['ssm_b_re'].astype(f32))
    bu_im = jnp.einsum('btgc,gpc->btgp', ug, p['ssm_b_im'].astype(f32))
    bb_re = g_re * bu_re - g_im * bu_im
    bb_im = g_re * bu_im + g_im * bu_re
    h0r, h0i = h0_re.astype(f32), h0_im.astype(f32)
    bb_re = bb_re.at[:, 0].add(lam_re * h0r - lam_im * h0i)
    bb_im = bb_im.at[:, 0].add(lam_re * h0i + lam_im * h0r)
    ar = jnp.broadcast_to(lam_re, bb_re.shape)
    ai = jnp.broadcast_to(lam_im, bb_im.shape)

    def combine(e1, e2):
        a1r, a1i, b1r, b1i = e1
        a2r, a2i, b2r, b2i = e2
        return (a2r * a1r - a2i * a1i,
                a2r * a1i + a2i * a1r,
                a2r * b1r - a2i * b1i + b2r,
                a2r * b1i + a2i * b1r + b2i)

    _, _, xr, xi = lax.associative_scan(combine, (ar, ai, bb_re, bb_im), axis=1)
    y = (jnp.einsum('btgp,gcp->btgc', xr, p['ssm_c_re'].astype(f32))
         - jnp.einsum('btgp,gcp->btgc', xi, p['ssm_c_im'].astype(f32))
         + p['ssm_d'].astype(f32).reshape(SSM_GROUPS, SSM_GROUP_CH) * ug)
    z = jax.nn.gelu(y.reshape(b, t, SSM_W))
    out = z * jax.nn.sigmoid(z @ p['ssm_w_glu'].astype(f32))
    return out.astype(u.dtype), xr[:, -1], xi[:, -1]


def mem_kv(mem, p):
    b = mem.shape[0]
    kv = rms_norm(mem, p['mem_norm']) @ p['w_mem_kv']
    k = kv[..., :MEM_W].reshape(b, N_MEM, MEM_HEADS, MEM_HEAD_DIM)
    v = kv[..., MEM_W:].reshape(b, N_MEM, MEM_HEADS, MEM_HEAD_DIM)
    return rms_norm(k, p['mem_k_norm']), v


def mem_attend(qm, mk, mv):
    scale = 1.0 / math.sqrt(MEM_HEAD_DIM)
    s = jnp.einsum('bqhd,bkhd->bhqk', qm.astype(jnp.float32), mk.astype(jnp.float32)) * scale
    pr = jax.nn.softmax(s, axis=-1)
    o = jnp.einsum('bhqk,bkhd->bqhd', pr, mv.astype(jnp.float32))
    return o.reshape(qm.shape[0], qm.shape[1], MEM_W).astype(qm.dtype)


def trunk_layer(x, pos, past_k, past_v, h0_re, h0_im, mk, mv, p):
    b, t = x.shape[0], x.shape[1]
    h = rms_norm(x, p['attn_norm'])
    z = h @ p['w_in']
    q = z[..., Q_OFF:K_OFF].reshape(b, t, N_HEADS, HEAD_DIM)
    k = z[..., K_OFF:V_OFF].reshape(b, t, N_KV_HEADS, HEAD_DIM)
    v = z[..., V_OFF:U_OFF].reshape(b, t, N_KV_HEADS, HEAD_DIM)
    u = z[..., U_OFF:MQ_OFF]
    qm = z[..., MQ_OFF:G_OFF].reshape(b, t, MEM_HEADS, MEM_HEAD_DIM)
    gates = jax.nn.sigmoid(z[..., G_OFF:].reshape(b, t, N_BRANCH, D_MODEL))
    q = rotary(rms_norm(q, p['q_norm']), pos)
    k = rotary(rms_norm(k, p['k_norm']), pos)
    if past_k is None:
        o_a = swa_prompt(q, k, v, p['attn_sinks'])
        new_k, new_v = k[:, -WINDOW:], v[:, -WINDOW:]
    else:
        o_a, new_k, new_v = swa_sample(q, k, v, past_k, past_v, p['attn_sinks'])
    o_b, hr, hi = ssm_branch(u, h0_re, h0_im, p)
    o_c = mem_attend(rms_norm(qm, p['mem_q_norm']), mk, mv)
    branches = jnp.stack([o_a, o_b, o_c], axis=2)
    proj = jnp.einsum('btnc,ncd->btnd', branches, p['w_branch'])
    merged = jnp.sum(gates * proj, axis=2)
    x = x + merged @ p['w_out']
    gu = rms_norm(x, p['ffn_norm']) @ p['w_ffn_up']
    x = x + (jax.nn.silu(gu[..., :D_FF]) * gu[..., D_FF:]) @ p['w_ffn_down']
    return x, new_k, new_v, hr, hi


def setup_inputs(seed: int = 0) -> dict:
    key = jax.random.key(seed)
    keys = jax.random.split(key, 40)
    counter = [0]
    f32 = jnp.float32

    def nxt():
        kk = keys[counter[0]]
        counter[0] += 1
        return kk

    def nrm(shape, scale=1.0):
        return jax.random.normal(nxt(), shape, f32) * scale

    def gain(shape):
        return 1.0 + 0.1 * nrm(shape)

    L = DEPTH
    return {
        'x_prompt': nrm((BATCH, SEQ, D_MODEL)),
        'x_sample': nrm((DEC_BATCH, DEC_SEQ, D_MODEL)),
        'cache_swa_k': nrm((L, DEC_BATCH, WINDOW, N_KV_HEADS, HEAD_DIM)),
        'cache_swa_v': nrm((L, DEC_BATCH, WINDOW, N_KV_HEADS, HEAD_DIM)),
        'state_ssm_re': nrm((L, DEC_BATCH, SSM_GROUPS, SSM_STATE), 0.5),
        'state_ssm_im': nrm((L, DEC_BATCH, SSM_GROUPS, SSM_STATE), 0.5),
        'cache_mem_k': nrm((L, DEC_BATCH, N_MEM, MEM_HEADS, MEM_HEAD_DIM)),
        'cache_mem_v': nrm((L, DEC_BATCH, N_MEM, MEM_HEADS, MEM_HEAD_DIM)),
        'mem_prompt': nrm((BATCH, N_MEM, D_MODEL)),
        'attn_norm': gain((L, D_MODEL)),
        'w_in': nrm((L, D_MODEL, IN_W), D_MODEL ** -0.5),
        'q_norm': gain((L, HEAD_DIM)),
        'k_norm': gain((L, HEAD_DIM)),
        'attn_sinks': nrm((L, N_HEADS), 0.5),
        'ssm_a_re': -0.5 + 0.01 * nrm((L, SSM_GROUPS, SSM_STATE)),
        'ssm_a_im': math.pi * jnp.arange(SSM_STATE, dtype=f32) + 0.01 * nrm((L, SSM_GROUPS, SSM_STATE)),
        'ssm_log_dt': jax.random.uniform(nxt(), (L, SSM_GROUPS), f32, math.log(1e-3), math.log(1e-1)),
        'ssm_b_re': nrm((L, SSM_GROUPS, SSM_STATE, SSM_GROUP_CH), (2 * SSM_GROUP_CH) ** -0.5),
        'ssm_b_im': nrm((L, SSM_GROUPS, SSM_STATE, SSM_GROUP_CH), (2 * SSM_GROUP_CH) ** -0.5),
        'ssm_c_re': nrm((L, SSM_GROUPS, SSM_GROUP_CH, SSM_STATE), SSM_STATE ** -0.5),
        'ssm_c_im': nrm((L, SSM_GROUPS, SSM_GROUP_CH, SSM_STATE), SSM_STATE ** -0.5),
        'ssm_d': nrm((L, SSM_W)),
        'ssm_w_glu': nrm((L, SSM_W, SSM_W), SSM_W ** -0.5),
        'mem_norm': gain((L, D_MODEL)),
        'w_mem_kv': nrm((L, D_MODEL, 2 * MEM_W), D_MODEL ** -0.5),
        'mem_q_norm': gain((L, MEM_HEAD_DIM)),
        'mem_k_norm': gain((L, MEM_HEAD_DIM)),
        'w_branch': nrm((L, N_BRANCH, BRANCH_W, D_MODEL), BRANCH_W ** -0.5),
        'w_out': nrm((L, D_MODEL, D_MODEL), D_MODEL ** -0.5),
        'ffn_norm': gain((L, D_MODEL)),
        'w_ffn_up': nrm((L, D_MODEL, 2 * D_FF), D_MODEL ** -0.5),
        'w_ffn_down': nrm((L, D_FF, D_MODEL), D_FF ** -0.5),
    }


def reference(x_prompt, x_sample, cache_swa_k, cache_swa_v, state_ssm_re, state_ssm_im,
              cache_mem_k, cache_mem_v, mem_prompt, attn_norm, w_in, q_norm, k_norm, attn_sinks,
              ssm_a_re, ssm_a_im, ssm_log_dt, ssm_b_re, ssm_b_im, ssm_c_re, ssm_c_im, ssm_d,
              ssm_w_glu, mem_norm, w_mem_kv, mem_q_norm, mem_k_norm, w_branch, w_out, ffn_norm,
              w_ffn_up, w_ffn_down):
    pos_p = jnp.arange(x_prompt.shape[1], dtype=jnp.float32)
    pos_s = PAST_LEN + jnp.arange(x_sample.shape[1], dtype=jnp.float32)
    h0 = jnp.zeros((x_prompt.shape[0], SSM_GROUPS, SSM_STATE), jnp.float32)
    y_p, y_s = x_prompt, x_sample
    kp_l, vp_l, hrp_l, hip_l, mkp_l, mvp_l = [], [], [], [], [], []
    ks_l, vs_l, hrs_l, his_l = [], [], [], []
    for l in range(DEPTH):
        p = {
            'attn_norm': attn_norm[l], 'w_in': w_in[l], 'q_norm': q_norm[l], 'k_norm': k_norm[l],
            'attn_sinks': attn_sinks[l], 'ssm_a_re': ssm_a_re[l], 'ssm_a_im': ssm_a_im[l],
            'ssm_log_dt': ssm_log_dt[l], 'ssm_b_re': ssm_b_re[l], 'ssm_b_im': ssm_b_im[l],
            'ssm_c_re': ssm_c_re[l], 'ssm_c_im': ssm_c_im[l], 'ssm_d': ssm_d[l],
            'ssm_w_glu': ssm_w_glu[l], 'mem_norm': mem_norm[l], 'w_mem_kv': w_mem_kv[l],
            'mem_q_norm': mem_q_norm[l], 'mem_k_norm': mem_k_norm[l], 'w_branch': w_branch[l],
            'w_out': w_out[l], 'ffn_norm': ffn_norm[l], 'w_ffn_up': w_ffn_up[l],
            'w_ffn_down': w_ffn_down[l],
        }
        mk_p, mv_p = mem_kv(mem_prompt, p)
        y_p, kp, vp, hrp, hip = trunk_layer(y_p, pos_p, None, None, h0, h0, mk_p, mv_p, p)
        y_s, ks, vs, hrs, his = trunk_layer(y_s, pos_s, cache_swa_k[l], cache_swa_v[l],
                                            state_ssm_re[l], state_ssm_im[l],
                                            cache_mem_k[l], cache_mem_v[l], p)
        kp_l.append(kp); vp_l.append(vp); hrp_l.append(hrp); hip_l.append(hip)
        mkp_l.append(mk_p); mvp_l.append(mv_p)
        ks_l.append(ks); vs_l.append(vs); hrs_l.append(hrs); his_l.append(his)
    swa_k_prompt = jnp.stack(kp_l)
    swa_v_prompt = jnp.stack(vp_l)
    ssm_re_prompt = jnp.stack(hrp_l)
    ssm_im_prompt = jnp.stack(hip_l)
    mem_k_prompt = jnp.stack(mkp_l)
    mem_v_prompt = jnp.stack(mvp_l)
    swa_k_sample = jnp.stack(ks_l)
    swa_v_sample = jnp.stack(vs_l)
    ssm_re_sample = jnp.stack(hrs_l)
    ssm_im_sample = jnp.stack(his_l)
    return (y_p, y_s, swa_k_prompt, swa_v_prompt, ssm_re_prompt, ssm_im_prompt,
            mem_k_prompt, mem_v_prompt, swa_k_sample, swa_v_sample, ssm_re_sample, ssm_im_sample)
```

```cpp
#include <hip/hip_runtime.h>
#include <hip/hip_cooperative_groups.h>
#include <cstdio>
#include <cstdint>
namespace cg = cooperative_groups;

#ifndef PHM
#define PHM 4095
#endif
#ifndef ITM
#define ITM 31
#endif
#ifndef REP_ATT
#define REP_ATT 1
#endif
#ifndef REP_SSM1
#define REP_SSM1 1
#endif
#ifndef REP_SSM2
#define REP_SSM2 1
#endif
#ifndef ONE_LAUNCH
#define ONE_LAUNCH 1
#endif

#define LAS __attribute__((address_space(3)))
typedef unsigned short bf16;
typedef short bf16x8 __attribute__((ext_vector_type(8)));
typedef short s16x4 __attribute__((ext_vector_type(4)));
typedef float f32x4 __attribute__((ext_vector_type(4)));
typedef unsigned u32x4 __attribute__((ext_vector_type(4)));
typedef unsigned u32x2 __attribute__((ext_vector_type(2)));

constexpr int DM = 1024, NB = 4, SEQ = 4096, DEPTH = 2, DBATCH = 128, DSEQ = 4;
constexpr int MP = NB * SEQ, MS = DBATCH * DSEQ, MT = MP + MS;
constexpr int INW = 4864, KO = 512, VO = 640, UO = 768, MQO = 1280, GO = 1792;
constexpr int DFF = 2816, NMEM = 256, MEMROWS = NB * NMEM;
constexpr float EPS = 1e-6f;
constexpr int NPOS = SEQ + DSEQ;
constexpr int PAST = 16384;

constexpr size_t O_YP = 0, O_YS = O_YP + (size_t)MP * DM, O_KP = O_YS + (size_t)MS * DM, O_VP = O_KP + 2 * 4 * 128 * 128,
                 O_HRP = O_VP + 2 * 4 * 128 * 128, O_HIP = O_HRP + 2 * 4 * 32 * 64, O_MKP = O_HIP + 2 * 4 * 32 * 64,
                 O_MVP = O_MKP + (size_t)2 * 4 * 256 * 512, O_KS = O_MVP + (size_t)2 * 4 * 256 * 512, O_VS = O_KS + (size_t)2 * 128 * 128 * 128,
                 O_HRS = O_VS + (size_t)2 * 128 * 128 * 128, O_HIS = O_HRS + (size_t)2 * 128 * 32 * 64, O_END = O_HIS + (size_t)2 * 128 * 32 * 64;

constexpr size_t MiB = 1u << 20;
constexpr size_t WS_ROPE = 1 * MiB, WS_LAM = 3 * MiB, WS_BP = 3 * MiB + 128 * 1024, WS_SST = 4 * MiB, WS_MEMN = 8 * MiB, WS_KVMEM = 10 * MiB,
                 WS_MK = 14 * MiB, WS_MV = 15 * MiB, WS_W = 16 * MiB, W_LAYER = 36 * MiB,
                 OFF_WIN = 0, OFF_WMKV = 10 * MiB, OFF_WGLU = 12 * MiB, OFF_WBR = 13 * MiB, OFF_WOUT = 16 * MiB, OFF_WUP = 18 * MiB, OFF_WDN = 29 * MiB + 512 * 1024,
                 WS_XN = 88 * MiB, WS_MERGED = 121 * MiB, WS_BR = 154 * MiB, WS_ZS = 204 * MiB, WS_Z = 221 * MiB, WS_H = WS_Z,
                 WS_LAMP = 378 * MiB, WS_BT1 = 380 * MiB, WS_BT2 = 396 * MiB, WS_A2 = 436 * MiB, WS_SS = 456 * MiB, WS_PART = 464 * MiB, WS_END = 486 * MiB;
static_assert(OFF_WDN + (size_t)1024 * 2816 * 2 <= W_LAYER, "weights");
static_assert(WS_Z + (size_t)MT * INW * 2 <= WS_LAMP, "Z");

constexpr int LDS_BYTES = 147456;
constexpr int NPS = 11;
constexpr int NPHASE = 1 + NPS * DEPTH;

struct Params { const float* in[32]; float* out; unsigned char* ws; int ph_lo, ph_hi; };

__device__ const double INVF[32] = {1.0,0.7498942093324559,0.5623413251903491,0.4216965034285822,0.31622776601683794,0.23713737056616552,0.1778279410038923,0.1333521432163324,0.1,0.07498942093324558,0.05623413251903491,0.042169650342858224,0.03162277660168379,0.023713737056616554,0.01778279410038923,0.01333521432163324,0.01,0.007498942093324558,0.005623413251903491,0.004216965034285823,0.0031622776601683794,0.0023713737056616554,0.0017782794100389228,0.001333521432163324,0.001,0.0007498942093324559,0.0005623413251903491,0.00042169650342858224,0.00031622776601683794,0.00023713737056616554,0.00017782794100389227,0.0001333521432163324};

__device__ __forceinline__ float bf2f(unsigned h) { return __uint_as_float(h << 16); }
__device__ __forceinline__ unsigned f2bf(float f) { unsigned u = __float_as_uint(f); return (u + 0x7fffu + ((u >> 16) & 1u)) >> 16; }
__device__ __forceinline__ unsigned pk2(float lo, float hi) { return f2bf(lo) | (f2bf(hi) << 16); }
typedef float f32x2_t __attribute__((ext_vector_type(2))); typedef __bf16 bf16x2_t __attribute__((ext_vector_type(2)));
__device__ __forceinline__ unsigned pk2h(float lo, float hi) { const f32x2_t v = {lo, hi}; const bf16x2_t b = __builtin_convertvector(v, bf16x2_t); return __builtin_bit_cast(unsigned, b); }
__device__ __forceinline__ float lo16(unsigned w) { return __uint_as_float(w << 16); }
__device__ __forceinline__ float hi16(unsigned w) { return __uint_as_float(w & 0xffff0000u); }
__device__ __forceinline__ float sigm(float x) { return __builtin_amdgcn_rcpf(1.0f + __builtin_amdgcn_exp2f(-1.4426950408889634f * x)); }
__device__ __forceinline__ float gelu_tanh(float y) { const float a = 0.7978845608028654f * (y + 0.044715f * y * y * y); const float th = 1.0f - 2.0f * __builtin_amdgcn_rcpf(__expf(2.0f * a) + 1.0f); return 0.5f * y * (1.0f + th); }
__device__ __forceinline__ float wave_sum(float v) {
#pragma unroll
    for (int o = 1; o < 64; o <<= 1) v += __shfl_xor(v, o);
    return v;
}
__device__ __forceinline__ void sincos_d(double x, double& s, double& c) {
    const double kd = rint(x * 0.63661977236758134308);
    double r = fma(-kd, 1.57079632679489655800e+00, x); r = fma(-kd, 6.12323399573676603587e-17, r);
    const int q = ((int)kd) & 3;
    const double r2 = r * r;
    const double sp = r * (1.0 + r2 * (-1.0 / 6.0 + r2 * (1.0 / 120.0 + r2 * (-1.0 / 5040.0 + r2 * (1.0 / 362880.0 + r2 * (-1.0 / 39916800.0 + r2 * (1.0 / 6227020800.0 + r2 * (-1.0 / 1307674368000.0 + r2 * (1.0 / 355687428096000.0)))))))));
    const double cp = 1.0 + r2 * (-0.5 + r2 * (1.0 / 24.0 + r2 * (-1.0 / 720.0 + r2 * (1.0 / 40320.0 + r2 * (-1.0 / 3628800.0 + r2 * (1.0 / 479001600.0 + r2 * (-1.0 / 87178291200.0 + r2 * (1.0 / 20922789888000.0))))))));
    s = (q == 0) ? sp : (q == 1) ? cp : (q == 2) ? -sp : -cp;
    c = (q == 0) ? cp : (q == 1) ? -sp : (q == 2) ? -cp : sp;
}

namespace pg8 {
#define PG8_LAS __attribute__((address_space(3)))
constexpr int BM = 256, BK = 64, HALF = 128, HTB = HALF * BK * 2, STAGE_BYTES = 8 * HTB, NXCD = 8, WGM = 4;
__host__ __device__ __forceinline__ int lds_byte(int r, int c) { const int st = (r >> 4) * 2 + (c >> 5), rr = r & 15, cc = c & 31, ob = rr * 64 + cc * 2; return st * 1024 + (ob ^ (((ob >> 9) & 1) << 5)); }
__host__ __device__ __forceinline__ void stage_rc(int b, int& R, int& C) { const int st = b / 1024, sb = b % 1024, swz = sb ^ (((sb >> 9) & 1) << 5); R = (st >> 1) * 16 + swz / 64; C = (st & 1) * 32 + (swz % 64) / 2; }
__host__ __device__ __forceinline__ int perm32(int rho) { const int n = rho >> 4, i = rho & 15; return 8 * (i >> 2) + 4 * n + (i & 3); }
struct Unit { int pm, pn, ko; };
struct Gemm { const bf16* A; const bf16* Bt; int M, N, K, lda, ldb; };
struct StaticOrder {
    int nM, nN, nwg, G, c;
    __host__ __device__ void init(int M, int N, int G_, int c_) { nM = M / BM; nN = N / BM; nwg = nM * nN; G = G_; c = c_; }
    __host__ __device__ bool next(int i, Unit& u) const {
        const long L = (long)i * G + c; if (L >= nwg) return false;
        int wgid = (int)L; { const int q = nwg / NXCD, r = nwg % NXCD, xcd = wgid % NXCD, off = wgid / NXCD; wgid = (xcd < r ? xcd * (q + 1) : r * (q + 1) + (xcd - r) * q) + off; }
        const int nig = WGM * nN, gid = wgid / nig, fm = gid * WGM, gsz = (nM - fm) < WGM ? (nM - fm) : WGM;
        u.pm = fm + ((wgid % nig) % gsz); u.pn = (wgid % nig) / gsz; u.ko = 0; return true;
    }
    __device__ __forceinline__ void a_ready(const Unit&) const {}
    __device__ __forceinline__ void done(const Unit&) const {}
};
struct GroupOrder {
    int G, c, nunits, mode;
    __device__ bool next(int i, Unit& u) const { int L = i * G + c; if (L >= nunits) return false;
        if (G == 256 && i == 0) { const int x = c & 7, y = c >> 3;
            L = (mode == 0) ? 2 * (x + 8 * (y >> 1)) + (y & 1) : 4 * (x + 8 * (y >> 2)) + (y & 3); }
        u.ko = 0; if (mode == 0) { u.pm = L; u.pn = L >> 1; } else { const int g = L >> 2; u.pm = 2 * g + ((L >> 1) & 1); u.pn = 2 * g + (L & 1); } return true; }
    __device__ __forceinline__ void a_ready(const Unit&) const {}
    __device__ __forceinline__ void done(const Unit&) const {}
};
struct RangeOrder {
    int G, c, pm0, nm, nn;
    __device__ bool next(int i, Unit& u) const { if (c < 0) return false; const int L = i * G + c; if (L >= nm * nn) return false; u.pm = pm0 + L / nn; u.pn = L % nn; u.ko = 0; return true; }
    __device__ __forceinline__ void a_ready(const Unit&) const {}
    __device__ __forceinline__ void done(const Unit&) const {}
};
struct TailOrder {
    int c, S, kslice_bytes, G;
    __device__ bool next(int i, Unit& u) const { const int L = i * G + c; if (c < 0 || L >= 8 * S) return false; const int un = L / S, ks = L - un * S; u.pm = 64 + (un >> 2); u.pn = un & 3; u.ko = ks * kslice_bytes; return true; }
    __device__ __forceinline__ void a_ready(const Unit&) const {}
    __device__ __forceinline__ void done(const Unit&) const {}
};
__device__ __forceinline__ u32x4 pack8(const f32x4 a, const f32x4 b) { u32x4 w; w.x = pk2h(a[0], a[1]); w.y = pk2h(a[2], a[3]); w.z = pk2h(b[0], b[1]); w.w = pk2h(b[2], b[3]); return w; }

struct EpiZ {
    static constexpr bool PERM = true, AFTER_DRAIN = false, HOOK = false;
    bf16* O; int ldc; int sig_from; bf16* A2;
    __device__ __forceinline__ void operator()(const f32x4 (&acc)[2][2][4][2], const Unit& u, int wr, int wc, int fr, int fq) const {
        const int row0 = u.pm * BM + wr * 64 + fr, col0 = u.pn * BM + wc * 32 + 8 * fq; const bool sg = u.pn >= sig_from;
#pragma unroll
        for (int ai = 0; ai < 2; ++ai)
#pragma unroll
            for (int m = 0; m < 4; ++m) { bf16* rowp = O + (size_t)(row0 + ai * HALF + m * 16) * ldc + col0;
#pragma unroll
                for (int bj = 0; bj < 2; ++bj) { f32x4 v0 = acc[ai][bj][m][0], v1 = acc[ai][bj][m][1];
                    if (sg) {
#pragma unroll
                        for (int e = 0; e < 4; ++e) { v0[e] = sigm(v0[e]); v1[e] = sigm(v1[e]); } }
                    const u32x4 pk = pack8(v0, v1); const bool utile = (u.pn == 3 || u.pn == 4) && u.pm < MP / BM;
                    if (!utile) *(u32x4*)(rowp + bj * HALF) = pk;
                    if (utile) { const int r = row0 + ai * HALF + m * 16, gg = (u.pn - 3) * 16 + bj * 8 + wc * 2 + (fq >> 1), t = r & (SEQ - 1);
                        *(u32x4*)(A2 + (size_t)(gg * 512 + (r >> 12) * 128 + (t >> 5)) * 640 + (t & 31) * 16 + (fq & 1) * 8) = pk; } } }
    }
};
struct EpiS {
    static constexpr bool PERM = false, AFTER_DRAIN = false, HOOK = false;
    float* SS;
    __device__ __forceinline__ void operator()(const f32x4 (&acc)[2][2][4][2], const Unit& u, int wr, int wc, int fr, int fq) const {
        const int row0 = u.pm * BM + wr * 64 + fr, col0 = wc * 32 + 4 * fq;
#pragma unroll
        for (int ai = 0; ai < 2; ++ai)
#pragma unroll
            for (int m = 0; m < 4; ++m) { float* rp = SS + (size_t)(row0 + ai * HALF + m * 16) * 128 + col0;
#pragma unroll
                for (int n = 0; n < 2; ++n) *(f32x4*)(rp + n * 16) = acc[ai][0][m][n]; }
    }
};
struct EpiY {
    static constexpr bool PERM = true, AFTER_DRAIN = false, HOOK = false;
    const bf16* A2; const float* Dv; bf16* ZS;
    __device__ __forceinline__ void operator()(const f32x4 (&acc)[2][2][4][2], const Unit& u, int wr, int wc, int fr, int fq) const {
        const int row0 = u.pm * BM + wr * 64 + fr, gg = u.pm >> 1, ct = u.pn & 1;
        const int cc0 = ct * 256 + wc * 32 + 8 * fq;
        const int c0 = cc0 & 15;
        const f32x4 d0 = *(const f32x4*)(Dv + gg * 16 + c0), d1 = *(const f32x4*)(Dv + gg * 16 + c0 + 4);
#pragma unroll
        for (int ai = 0; ai < 2; ++ai) { u32x4 uv[4][2];
#pragma unroll
            for (int m = 0; m < 4; ++m)
#pragma unroll
                for (int bj = 0; bj < 2; ++bj) uv[m][bj] = *(const u32x4*)(A2 + (size_t)(row0 + ai * HALF + m * 16) * 640 + ((cc0 + bj * HALF) >> 4) * 16 + c0);
            __builtin_amdgcn_sched_barrier(0);
#pragma unroll
            for (int m = 0; m < 4; ++m) { const int grow = row0 + ai * HALF + m * 16, bjr = grow & 511, b = bjr >> 7, j = bjr & 127;
#pragma unroll
                for (int bj = 0; bj < 2; ++bj) { const int t = (cc0 + bj * HALF) >> 4; const u32x4 uu = uv[m][bj];
                    const f32x4 a0 = acc[ai][bj][m][0], a1 = acc[ai][bj][m][1]; f32x4 v0, v1;
                    v0[0] = gelu_tanh(fmaf(d0[0], lo16(uu.x), a0[0])); v0[1] = gelu_tanh(fmaf(d0[1], hi16(uu.x), a0[1])); v0[2] = gelu_tanh(fmaf(d0[2], lo16(uu.y), a0[2])); v0[3] = gelu_tanh(fmaf(d0[3], hi16(uu.y), a0[3]));
                    v1[0] = gelu_tanh(fmaf(d1[0], lo16(uu.z), a1[0])); v1[1] = gelu_tanh(fmaf(d1[1], hi16(uu.z), a1[1])); v1[2] = gelu_tanh(fmaf(d1[2], lo16(uu.w), a1[2])); v1[3] = gelu_tanh(fmaf(d1[3], hi16(uu.w), a1[3]));
                    *(u32x4*)(ZS + (size_t)(b * SEQ + 32 * j + t) * 512 + gg * 16 + c0) = pack8(v0, v1); } }
            __builtin_amdgcn_sched_barrier(0); }
    }
};
struct EpiF32 {
    static constexpr bool PERM = false, AFTER_DRAIN = false, HOOK = false;
    float* O; int ldc;
    __device__ __forceinline__ void operator()(const f32x4 (&acc)[2][2][4][2], const Unit& u, int wr, int wc, int fr, int fq) const {
        const int row0 = u.pm * BM + wr * 64 + fr, col0 = u.pn * BM + wc * 32 + 4 * fq;
#pragma unroll
        for (int ai = 0; ai < 2; ++ai)
#pragma unroll
            for (int m = 0; m < 4; ++m) { float* rowp = O + (size_t)(row0 + ai * HALF + m * 16) * ldc + col0;
#pragma unroll
                for (int bj = 0; bj < 2; ++bj)
#pragma unroll
                    for (int n = 0; n < 2; ++n) *(f32x4*)(rowp + bj * HALF + n * 16) = acc[ai][bj][m][n]; }
    }
};
struct EpiRes {
    static constexpr bool PERM = false, AFTER_DRAIN = false, HOOK = false;
    const float* base_p; const float* base_s; float* out; int ldc;
    __device__ __forceinline__ void operator()(const f32x4 (&acc)[2][2][4][2], const Unit& u, int wr, int wc, int fr, int fq) const {
        const int row0 = u.pm * BM + wr * 64 + fr, col0 = u.pn * BM + wc * 32 + 4 * fq;
#pragma unroll
        for (int ai = 0; ai < 2; ++ai) { f32x4 bs[4][2][2];
#pragma unroll
            for (int m = 0; m < 4; ++m) { const int r = row0 + ai * HALF + m * 16; const float* bp = (r < MP) ? base_p + (size_t)r * ldc : base_s + (size_t)(r - MP) * ldc;
#pragma unroll
                for (int bj = 0; bj < 2; ++bj)
#pragma unroll
                    for (int n = 0; n < 2; ++n) bs[m][bj][n] = *(const f32x4*)(bp + col0 + bj * HALF + n * 16); }
            __builtin_amdgcn_sched_barrier(0);
#pragma unroll
            for (int m = 0; m < 4; ++m) { float* op = out + (size_t)(row0 + ai * HALF + m * 16) * ldc;
#pragma unroll
                for (int bj = 0; bj < 2; ++bj)
#pragma unroll
                    for (int n = 0; n < 2; ++n) *(f32x4*)(op + col0 + bj * HALF + n * 16) = bs[m][bj][n] + acc[ai][bj][m][n]; }
            __builtin_amdgcn_sched_barrier(0); }
    }
};
struct EpiGatePart {
    static constexpr bool PERM = false, AFTER_DRAIN = false, HOOK = false;
    const bf16* Z; float* part;
    __device__ __forceinline__ void operator()(const f32x4 (&acc)[2][2][4][2], const Unit& u, int wr, int wc, int fr, int fq) const {
        const int n = u.ko / 1024; const int row0 = u.pm * BM + wr * 64 + fr, col0 = u.pn * BM + wc * 32 + 4 * fq;
#pragma unroll
        for (int ai = 0; ai < 2; ++ai) { u32x2 gg[4][2][2];
#pragma unroll
            for (int m = 0; m < 4; ++m)
#pragma unroll
                for (int bj = 0; bj < 2; ++bj)
#pragma unroll
                    for (int nn = 0; nn < 2; ++nn) gg[m][bj][nn] = *(const u32x2*)(Z + (size_t)(row0 + ai * HALF + m * 16) * INW + GO + n * 1024 + col0 + bj * HALF + nn * 16);
            __builtin_amdgcn_sched_barrier(0);
#pragma unroll
            for (int m = 0; m < 4; ++m) { float* op = part + ((size_t)n * MS + (row0 - MP) + ai * HALF + m * 16) * DM + col0;
#pragma unroll
                for (int bj = 0; bj < 2; ++bj)
#pragma unroll
                    for (int nn = 0; nn < 2; ++nn) { const u32x2 g = gg[m][bj][nn]; const f32x4 a = acc[ai][bj][m][nn];
                        *(f32x4*)(op + bj * HALF + nn * 16) = (f32x4){a[0] * lo16(g.x), a[1] * hi16(g.x), a[2] * lo16(g.y), a[3] * hi16(g.y)}; } }
            __builtin_amdgcn_sched_barrier(0); }
    }
};
struct EpiPart {
    static constexpr bool PERM = false, AFTER_DRAIN = false, HOOK = false;
    float* part; int kslice_bytes;
    __device__ __forceinline__ void operator()(const f32x4 (&acc)[2][2][4][2], const Unit& u, int wr, int wc, int fr, int fq) const {
        const int ks = u.ko / kslice_bytes; const int row0 = (u.pm - 64) * BM + wr * 64 + fr, col0 = u.pn * BM + wc * 32 + 4 * fq;
#pragma unroll
        for (int ai = 0; ai < 2; ++ai)
#pragma unroll
            for (int m = 0; m < 4; ++m) { float* op = part + ((size_t)ks * MS + row0 + ai * HALF + m * 16) * DM + col0;
#pragma unroll
                for (int bj = 0; bj < 2; ++bj)
#pragma unroll
                    for (int n = 0; n < 2; ++n) *(f32x4*)(op + bj * HALF + n * 16) = acc[ai][bj][m][n]; }
    }
};
struct EpiGlu {
    static constexpr bool PERM = true, AFTER_DRAIN = false, HOOK = false;
    const bf16* ZS; bf16* BR;
    __device__ __forceinline__ void operator()(const f32x4 (&acc)[2][2][4][2], const Unit& u, int wr, int wc, int fr, int fq) const {
        const int row0 = u.pm * BM + wr * 64 + fr, col0 = u.pn * BM + wc * 32 + 8 * fq;
#pragma unroll
        for (int ai = 0; ai < 2; ++ai) { u32x4 zz[4][2];
#pragma unroll
            for (int m = 0; m < 4; ++m)
#pragma unroll
                for (int bj = 0; bj < 2; ++bj) zz[m][bj] = *(const u32x4*)(ZS + (size_t)(row0 + ai * HALF + m * 16) * 512 + col0 + bj * HALF);
            __builtin_amdgcn_sched_barrier(0);
#pragma unroll
            for (int m = 0; m < 4; ++m) { const int r = row0 + ai * HALF + m * 16;
#pragma unroll
                for (int bj = 0; bj < 2; ++bj) { const int c = col0 + bj * HALF; const u32x4 z = zz[m][bj];
                    const f32x4 a0 = acc[ai][bj][m][0], a1 = acc[ai][bj][m][1]; f32x4 v0, v1;
                    v0[0] = lo16(z.x) * sigm(a0[0]); v0[1] = hi16(z.x) * sigm(a0[1]); v0[2] = lo16(z.y) * sigm(a0[2]); v0[3] = hi16(z.y) * sigm(a0[3]);
                    v1[0] = lo16(z.z) * sigm(a1[0]); v1[1] = hi16(z.z) * sigm(a1[1]); v1[2] = lo16(z.w) * sigm(a1[2]); v1[3] = hi16(z.w) * sigm(a1[3]);
                    *(u32x4*)(BR + (size_t)r * 1536 + 512 + c) = pack8(v0, v1); } }
            __builtin_amdgcn_sched_barrier(0); }
    }
};
struct EpiSwiglu {
    static constexpr bool PERM = true, AFTER_DRAIN = false, HOOK = false;
    bf16* H;
    __device__ __forceinline__ void operator()(const f32x4 (&acc)[2][2][4][2], const Unit& u, int wr, int wc, int fr, int fq) const {
        const int row0 = u.pm * BM + wr * 64 + fr, col0 = u.pn * HALF + wc * 32 + 8 * fq;
#pragma unroll
        for (int ai = 0; ai < 2; ++ai)
#pragma unroll
            for (int m = 0; m < 4; ++m) { const int r = row0 + ai * HALF + m * 16; f32x4 v0, v1;
#pragma unroll
                for (int e = 0; e < 4; ++e) { const float g0 = acc[ai][0][m][0][e], g1 = acc[ai][0][m][1][e]; v0[e] = g0 * sigm(g0) * acc[ai][1][m][0][e]; v1[e] = g1 * sigm(g1) * acc[ai][1][m][1][e]; }
                *(u32x4*)(H + (size_t)r * DFF + col0) = pack8(v0, v1); }
    }
};
struct EpiMerge {
    static constexpr bool PERM = true, AFTER_DRAIN = false, HOOK = true;
    const bf16* Z; bf16* O;
    __device__ __forceinline__ void hook(f32x4 (&acc)[2][2][4][2], const Unit& u, int t, int wr, int wc, int fr, int fq) const {
        const int n = (t >> 3) - 1; int frx = fr, fqx = fq; asm volatile("" : "+v"(frx), "+v"(fqx)); const int row0 = u.pm * BM + wr * 64 + frx, col0 = u.pn * BM + wc * 32 + 8 * fqx;
#pragma unroll
        for (int ai = 0; ai < 2; ++ai) { u32x4 ga[4][2], gb[4][2];
#pragma unroll
            for (int m = 0; m < 4; ++m) { const bf16* zr = Z + (size_t)(row0 + ai * HALF + m * 16) * INW + GO + n * 1024 + col0;
#pragma unroll
                for (int bj = 0; bj < 2; ++bj) { ga[m][bj] = *(const u32x4*)(zr + bj * HALF); gb[m][bj] = *(const u32x4*)(zr + 1024 + bj * HALF); } }
            __builtin_amdgcn_sched_barrier(0);
#pragma unroll
            for (int m = 0; m < 4; ++m)
#pragma unroll
                for (int bj = 0; bj < 2; ++bj) { const unsigned aw[4] = {ga[m][bj].x, ga[m][bj].y, ga[m][bj].z, ga[m][bj].w}, bw[4] = {gb[m][bj].x, gb[m][bj].y, gb[m][bj].z, gb[m][bj].w};
#pragma unroll
                    for (int e = 0; e < 4; ++e) { const float r0 = fmaxf(lo16(aw[e]), 1e-20f) * __builtin_amdgcn_rcpf(fmaxf(lo16(bw[e]), 1e-20f)), r1 = fmaxf(hi16(aw[e]), 1e-20f) * __builtin_amdgcn_rcpf(fmaxf(hi16(bw[e]), 1e-20f));
                        acc[ai][bj][m][e >> 1][(e & 1) * 2] *= r0; acc[ai][bj][m][e >> 1][(e & 1) * 2 + 1] *= r1; } }
            __builtin_amdgcn_sched_barrier(0); }
    }
    __device__ __forceinline__ void operator()(const f32x4 (&acc)[2][2][4][2], const Unit& u, int wr, int wc, int fr, int fq) const {
        const int row0 = u.pm * BM + wr * 64 + fr, col0 = u.pn * BM + wc * 32 + 8 * fq;
#pragma unroll
        for (int ai = 0; ai < 2; ++ai) { u32x4 gg[4][2];
#pragma unroll
            for (int m = 0; m < 4; ++m)
#pragma unroll
                for (int bj = 0; bj < 2; ++bj) gg[m][bj] = *(const u32x4*)(Z + (size_t)(row0 + ai * HALF + m * 16) * INW + GO + 2048 + col0 + bj * HALF);
            __builtin_amdgcn_sched_barrier(0);
#pragma unroll
            for (int m = 0; m < 4; ++m) { const int r = row0 + ai * HALF + m * 16;
#pragma unroll
                for (int bj = 0; bj < 2; ++bj) { const unsigned gw[4] = {gg[m][bj].x, gg[m][bj].y, gg[m][bj].z, gg[m][bj].w}; f32x4 v0, v1;
#pragma unroll
                    for (int e = 0; e < 2; ++e) { v0[2 * e] = acc[ai][bj][m][0][2 * e] * fmaxf(lo16(gw[e]), 1e-20f); v0[2 * e + 1] = acc[ai][bj][m][0][2 * e + 1] * fmaxf(hi16(gw[e]), 1e-20f);
                        v1[2 * e] = acc[ai][bj][m][1][2 * e] * fmaxf(lo16(gw[2 + e]), 1e-20f); v1[2 * e + 1] = acc[ai][bj][m][1][2 * e + 1] * fmaxf(hi16(gw[2 + e]), 1e-20f); }
                    *(u32x4*)(O + (size_t)r * DM + col0 + bj * HALF) = pack8(v0, v1); } }
            __builtin_amdgcn_sched_barrier(0); }
    }
};

template <class Epi, class Sched, bool ALIGN_EPI = false, bool SP2 = false>
__device__ __forceinline__ void gemm_phase(PG8_LAS unsigned char* lds, const Gemm g, const Sched& S, const Epi& E) {
    const int tid = threadIdx.x, wid = __builtin_amdgcn_readfirstlane(tid >> 6), lane = tid & 63, wr = wid >> 2, wc = wid & 3, fr = lane & 15, fq = lane >> 4;
    const int K = g.K, nt = K / BK, lda = g.lda, ldb = g.ldb;
    unsigned voffA[2], voffB[2];
#pragma unroll
    for (int i = 0; i < 2; ++i) { int R, C; stage_rc(tid * 16 + i * 8192, R, C); const int Rb = Epi::PERM ? ((R & ~31) + perm32(R & 31)) : R;
        voffA[i] = (unsigned)(R * lda + C) * 2u; voffB[i] = (unsigned)(Rb * ldb + C) * 2u; }
    const size_t kstep = (size_t)(BK * 2);
    const size_t hstep = (size_t)HALF * ldb * 2;
    const size_t tstep = 2 * hstep;
    const size_t hstepA = (size_t)HALF * lda * 2, tstepA = 2 * hstepA;
    const unsigned ldsw = (unsigned)wid * 1024u;
    const int aoff = lds_byte(wr * 64 + fr, fq * 8), boff = lds_byte(wc * 32 + fr, fq * 8);
#define PG8_SA(b, h) (((b) * 2 + (h)) * HTB)
#define PG8_SB(b, h) ((4 + (b) * 2 + (h)) * HTB)
#define PG8_STAGE(bufoff, gbase, voff) do { _Pragma("unroll") for (int _i = 0; _i < 2; ++_i) \
        __builtin_amdgcn_global_load_lds((const unsigned*)((const char*)(gbase) + (voff)[_i]), (PG8_LAS unsigned*)(lds + (bufoff) + ldsw + _i * 8192), 16, 0, 0); } while (0)
#define PG8_LDA(dst, b, h) do { _Pragma("unroll") for (int m = 0; m < 4; ++m) _Pragma("unroll") for (int k = 0; k < 2; ++k) dst[m][k] = *(const PG8_LAS bf16x8*)(lds + PG8_SA(b, h) + aoff + m * 2048 + k * 1024); } while (0)
#define PG8_LDB(dst, b, h) do { _Pragma("unroll") for (int n = 0; n < 2; ++n) _Pragma("unroll") for (int k = 0; k < 2; ++k) dst[n][k] = *(const PG8_LAS bf16x8*)(lds + PG8_SB(b, h) + boff + n * 2048 + k * 1024); } while (0)
#define PG8_MMA(ai, bj, At, Bt) do { __builtin_amdgcn_s_setprio(1); _Pragma("unroll") for (int m = 0; m < 4; ++m) _Pragma("unroll") for (int n = 0; n < 2; ++n) _Pragma("unroll") for (int k = 0; k < 2; ++k) \
        acc[ai][bj][m][n] = __builtin_amdgcn_mfma_f32_16x16x32_bf16(Bt[n][k], At[m][k], acc[ai][bj][m][n], 0, 0, 0); __builtin_amdgcn_s_setprio(0); } while (0)
#define PG8_WAIT_V(n) asm volatile("s_waitcnt vmcnt(" #n ")" ::: "memory")
#define PG8_WAIT_L(n) asm volatile("s_waitcnt lgkmcnt(" #n ")" ::: "memory")
#define PG8_BAR __builtin_amdgcn_s_barrier()
#define PG8_SCHED __builtin_amdgcn_sched_barrier(0)
    Unit cur, nxt; int ui = 0;
    if (!S.next(0, cur)) return;
    f32x4 acc[2][2][4][2];
#pragma unroll
    for (int a = 0; a < 2; ++a)
#pragma unroll
        for (int b = 0; b < 2; ++b)
#pragma unroll
            for (int m = 0; m < 4; ++m)
#pragma unroll
                for (int n = 0; n < 2; ++n) acc[a][b][m][n] = (f32x4){0.f, 0.f, 0.f, 0.f};
    bf16x8 At[4][2], B0[2][2], B1[2][2];
    const char* cA = (const char*)g.A + (size_t)cur.pm * tstepA + cur.ko; const char* cB = (const char*)g.Bt + (size_t)cur.pn * tstep + cur.ko;
    S.a_ready(cur);
    if constexpr (SP2) {
        PG8_STAGE(PG8_SB(0, 0), cB, voffB); PG8_STAGE(PG8_SB(0, 1), cB + hstep, voffB); PG8_STAGE(PG8_SA(0, 0), cA, voffA); PG8_STAGE(PG8_SA(0, 1), cA + hstepA, voffA);
        if (wr == 1) PG8_BAR;
        PG8_WAIT_V(2); PG8_BAR;
        PG8_STAGE(PG8_SB(1, 0), cB + kstep, voffB); PG8_STAGE(PG8_SA(1, 0), cA + kstep, voffA); PG8_STAGE(PG8_SB(1, 1), cB + hstep + kstep, voffB);
        PG8_WAIT_V(6); PG8_BAR;
    } else {
        PG8_STAGE(PG8_SB(0, 0), cB, voffB); PG8_STAGE(PG8_SA(0, 0), cA, voffA); PG8_STAGE(PG8_SB(0, 1), cB + hstep, voffB); PG8_STAGE(PG8_SA(0, 1), cA + hstepA, voffA);
        if (wr == 1) PG8_BAR;
        PG8_WAIT_V(4); PG8_BAR;
        PG8_STAGE(PG8_SB(1, 0), cB + kstep, voffB); PG8_STAGE(PG8_SA(1, 0), cA + kstep, voffA); PG8_STAGE(PG8_SB(1, 1), cB + hstep + kstep, voffB);
        PG8_WAIT_V(6); PG8_BAR;
    }
    for (;;) {
        const bool has_next = S.next(ui + 1, nxt);
        const char* nA = has_next ? (const char*)g.A + (size_t)nxt.pm * tstepA + nxt.ko : cA; const char* nB = has_next ? (const char*)g.Bt + (size_t)nxt.pn * tstep + nxt.ko : cB;
        for (int t = 0; t < nt; t += 2) {
            const bool last = (t == nt - 2);
            const char* a1 = cA + (size_t)(t + 1) * kstep;
            const char* a2 = last ? nA : cA + (size_t)(t + 2) * kstep; const char* b2 = last ? nB : cB + (size_t)(t + 2) * kstep;
            const char* a3 = a2 + kstep; const char* b3 = b2 + kstep;
            if (last && has_next) S.a_ready(nxt);
            if constexpr (Epi::HOOK) { if (t == 8 || t == 16) E.hook(acc, cur, t, wr, wc, fr, fq); }
            if constexpr (SP2) {
            PG8_LDB(B0, 0, 0); PG8_LDB(B1, 0, 1); PG8_SCHED; PG8_LDA(At, 0, 0); PG8_STAGE(PG8_SA(1, 1), a1 + hstepA, voffA);
            PG8_WAIT_V(8); PG8_WAIT_L(0); PG8_BAR; PG8_MMA(0, 0, At, B0); PG8_MMA(0, 1, At, B1); PG8_BAR; PG8_SCHED;
            PG8_LDA(At, 0, 1); PG8_STAGE(PG8_SB(0, 0), b2, voffB); PG8_STAGE(PG8_SB(0, 1), b2 + hstep, voffB); PG8_STAGE(PG8_SA(0, 0), a2, voffA);
            PG8_WAIT_V(8); PG8_WAIT_L(0); PG8_BAR; PG8_MMA(1, 0, At, B0); PG8_MMA(1, 1, At, B1); PG8_BAR; PG8_SCHED;
            PG8_LDB(B0, 1, 0); PG8_LDB(B1, 1, 1); PG8_SCHED; PG8_LDA(At, 1, 0); PG8_STAGE(PG8_SA(0, 1), a2 + hstepA, voffA);
            PG8_WAIT_V(8); PG8_WAIT_L(0); PG8_BAR; PG8_MMA(0, 0, At, B0); PG8_MMA(0, 1, At, B1); PG8_BAR; PG8_SCHED;
            PG8_LDA(At, 1, 1); PG8_STAGE(PG8_SB(1, 0), b3, voffB); PG8_STAGE(PG8_SB(1, 1), b3 + hstep, voffB); PG8_STAGE(PG8_SA(1, 0), a3, voffA);
            PG8_WAIT_V(8); PG8_WAIT_L(0); PG8_BAR; PG8_MMA(1, 0, At, B0); PG8_MMA(1, 1, At, B1); PG8_BAR; PG8_SCHED;
            } else {
            PG8_LDB(B0, 0, 0); PG8_SCHED; PG8_LDA(At, 0, 0); PG8_STAGE(PG8_SA(1, 1), a1 + hstepA, voffA);
            PG8_WAIT_L(8); PG8_BAR; PG8_WAIT_L(0); PG8_MMA(0, 0, At, B0); PG8_BAR; PG8_SCHED;
            PG8_LDB(B1, 0, 1); PG8_STAGE(PG8_SB(0, 0), b2, voffB);
            PG8_BAR; PG8_WAIT_L(0); PG8_MMA(0, 1, At, B1); PG8_BAR;
            PG8_LDA(At, 0, 1); PG8_STAGE(PG8_SA(0, 0), a2, voffA);
            PG8_BAR; PG8_WAIT_L(0); PG8_MMA(1, 0, At, B0); PG8_BAR; PG8_SCHED;
            PG8_STAGE(PG8_SB(0, 1), b2 + hstep, voffB);
            PG8_WAIT_V(6); PG8_BAR; PG8_MMA(1, 1, At, B1); PG8_BAR;
            PG8_LDB(B0, 1, 0); PG8_SCHED; PG8_LDA(At, 1, 0); PG8_STAGE(PG8_SA(0, 1), a2 + hstepA, voffA);
            PG8_WAIT_L(8); PG8_BAR; PG8_WAIT_L(0); PG8_MMA(0, 0, At, B0); PG8_BAR; PG8_SCHED;
            PG8_LDB(B1, 1, 1); PG8_STAGE(PG8_SB(1, 0), b3, voffB);
            PG8_BAR; PG8_WAIT_L(0); PG8_MMA(0, 1, At, B1); PG8_BAR;
            PG8_LDA(At, 1, 1); PG8_STAGE(PG8_SA(1, 0), a3, voffA);
            PG8_BAR; PG8_WAIT_L(0); PG8_MMA(1, 0, At, B0); PG8_BAR; PG8_SCHED;
            PG8_STAGE(PG8_SB(1, 1), b3 + hstep, voffB);
            PG8_WAIT_V(6); PG8_BAR; PG8_MMA(1, 1, At, B1); PG8_BAR;
            }
        }
        if constexpr (ALIGN_EPI) { if (wr == 0) PG8_BAR; }
        if constexpr (!Epi::AFTER_DRAIN) { E(acc, cur, wr, wc, fr, fq); S.done(cur); }
        if (!has_next) break;
#pragma unroll
        for (int a = 0; a < 2; ++a)
#pragma unroll
            for (int b = 0; b < 2; ++b)
#pragma unroll
                for (int m = 0; m < 4; ++m)
#pragma unroll
                    for (int n = 0; n < 2; ++n) acc[a][b][m][n] = (f32x4){0.f, 0.f, 0.f, 0.f};
        cur = nxt; cA = nA; cB = nB; ++ui;
        if constexpr (ALIGN_EPI) { if (wr == 1) PG8_BAR; }
    }
    PG8_WAIT_V(0);
    if constexpr (!ALIGN_EPI) { if (wr == 0) PG8_BAR; }
    PG8_BAR;
#undef PG8_SA
#undef PG8_SB
#undef PG8_STAGE
#undef PG8_LDA
#undef PG8_LDB
#undef PG8_MMA
#undef PG8_WAIT_V
#undef PG8_WAIT_L
#undef PG8_BAR
#undef PG8_SCHED
}
}

__device__ __forceinline__ void transpose_item(const float* W, int N, bf16* WT, int ldt, int koff, const float* gain, int upperm, LAS float* scr, int kb, int nb, int lane) {
    const int k0 = 64 * kb, n0 = 64 * nb;
    f32x4 v[16]; float gv[16];
#pragma unroll
    for (int i = 0; i < 16; ++i) { const int kk = 4 * i + (lane >> 4); v[i] = *(const f32x4*)(W + (size_t)(k0 + kk) * N + n0 + (lane & 15) * 4); gv[i] = gain ? gain[k0 + kk] : 1.0f; }
    __builtin_amdgcn_sched_barrier(0);
#pragma unroll
    for (int i = 0; i < 16; ++i) { const int kk = 4 * i + (lane >> 4); const float gg = gv[i]; LAS float* s = scr + kk * 65 + (lane & 15) * 4;
        s[0] = v[i].x * gg; s[1] = v[i].y * gg; s[2] = v[i].z * gg; s[3] = v[i].w * gg; }
    asm volatile("s_waitcnt lgkmcnt(0)" ::: "memory");
    const int c = lane & 7;
#pragma unroll
    for (int j = 0; j < 8; ++j) { const int n = (lane >> 3) + 8 * j; const LAS float* s = scr + (8 * c) * 65 + n;
        u32x4 o; o.x = pk2h(s[0 * 65], s[1 * 65]); o.y = pk2h(s[2 * 65], s[3 * 65]); o.z = pk2h(s[4 * 65], s[5 * 65]); o.w = pk2h(s[6 * 65], s[7 * 65]);
        int dr = n0 + n; if (upperm) { dr = (dr < DFF) ? (dr >> 7) * 256 + (dr & 127) : ((dr - DFF) >> 7) * 256 + 128 + ((dr - DFF) & 127); }
        *(u32x4*)(WT + (size_t)dr * ldt + koff + k0 + 8 * c) = o; }
    asm volatile("s_waitcnt lgkmcnt(0)" ::: "memory");
}
constexpr int TI_WIN = 16 * 76, TI_MKV = 16 * 16, TI_GLU = 8 * 8, TI_BR = 8 * 16, TI_OUT = 16 * 16, TI_UP = 16 * 88, TI_DN = 44 * 16;
constexpr int TI_LAYER = TI_WIN + TI_MKV + TI_GLU + 3 * TI_BR + TI_OUT + TI_UP + TI_DN;
__device__ __forceinline__ void weight_item(const Params& P, int it, LAS float* scr, int lane) {
    const int l = it / TI_LAYER; int r = it % TI_LAYER;
    unsigned char* wb = P.ws + WS_W + (size_t)l * W_LAYER;
    const float* W; int N; bf16* WT; int ldt, koff = 0, up = 0; const float* gain = nullptr;
    if (r < TI_WIN) { W = P.in[10] + (size_t)l * DM * INW; N = INW; WT = (bf16*)(wb + OFF_WIN); ldt = DM; gain = P.in[9] + l * DM; }
    else if ((r -= TI_WIN) < TI_MKV) { W = P.in[24] + (size_t)l * DM * 1024; N = 1024; WT = (bf16*)(wb + OFF_WMKV); ldt = DM; gain = P.in[23] + l * DM; }
    else if ((r -= TI_MKV) < TI_GLU) { W = P.in[22] + (size_t)l * 512 * 512; N = 512; WT = (bf16*)(wb + OFF_WGLU); ldt = 512; }
    else if ((r -= TI_GLU) < 3 * TI_BR) { const int nbr = r / TI_BR; r -= nbr * TI_BR; W = P.in[27] + ((size_t)l * 3 + nbr) * 512 * DM; N = DM; WT = (bf16*)(wb + OFF_WBR); ldt = 1536; koff = nbr * 512; }
    else if ((r -= 3 * TI_BR) < TI_OUT) { W = P.in[28] + (size_t)l * DM * DM; N = DM; WT = (bf16*)(wb + OFF_WOUT); ldt = DM; }
    else if ((r -= TI_OUT) < TI_UP) { W = P.in[30] + (size_t)l * DM * 2 * DFF; N = 2 * DFF; WT = (bf16*)(wb + OFF_WUP); ldt = DM; gain = P.in[29] + l * DM; up = 1; }
    else { r -= TI_UP; W = P.in[31] + (size_t)l * DFF * DM; N = DM; WT = (bf16*)(wb + OFF_WDN); ldt = DFF; }
    const int nblk = N / 64;
    transpose_item(W, N, WT, ldt, koff, gain, up, scr, r / nblk, r % nblk, lane);
}
__device__ __forceinline__ void rms_row_to_bf16(const float* xrow, bf16* orow, int lane, const float* part = nullptr, int npart = 0, float* xout = nullptr, bool want_xn = true) {
    const f32x4* xr = (const f32x4*)xrow + lane;
    f32x4 v[4]; float s = 0.f;
#pragma unroll
    for (int j = 0; j < 4; ++j) v[j] = xr[64 * j];
    if (part) { for (int k = 0; k < npart; ++k) { const f32x4* pr = (const f32x4*)(part + (size_t)k * MS * DM) + lane;
#pragma unroll
            for (int j = 0; j < 4; ++j) v[j] += pr[64 * j]; }
#pragma unroll
        for (int j = 0; j < 4; ++j) ((f32x4*)xout + lane)[64 * j] = v[j]; }
    if (!want_xn) return;
#pragma unroll
    for (int j = 0; j < 4; ++j) s += (v[j].x * v[j].x + v[j].y * v[j].y) + (v[j].z * v[j].z + v[j].w * v[j].w);
    const float rstd = 1.0f / sqrtf(wave_sum(s) * (1.f / DM) + EPS);
    u32x2* o8 = (u32x2*)orow + lane;
#pragma unroll
    for (int j = 0; j < 4; ++j) { u32x2 w; w.x = pk2(v[j].x * rstd, v[j].y * rstd); w.y = pk2(v[j].z * rstd, v[j].w * rstd); o8[64 * j] = w; }
}

template <bool OUT, int NPRE = 0>
__device__ __forceinline__ void ssm_run(const bf16* Zu, int L, float lr, float li, const float (&br)[16], const float (&bi)[16], float& hr, float& hi,
                                        const float (&cr)[16], const float (&ci)[16], float dcl, bf16* zs_out, int lane) {
    const int cl = lane >> 2;
    u32x4 pu0[NPRE > 0 ? NPRE : 1], pu1[NPRE > 0 ? NPRE : 1]; unsigned short pcl[NPRE > 0 ? NPRE : 1];
    if constexpr (NPRE > 0) {
#pragma unroll
        for (int t = 0; t < NPRE; ++t) { const bf16* up = Zu + (size_t)t * INW; pu0[t] = *(const u32x4*)up; pu1[t] = *(const u32x4*)(up + 8); pcl[t] = up[cl]; }
        __builtin_amdgcn_sched_barrier(0);
    }
#pragma unroll
    for (int t = 0; t < (NPRE > 0 ? NPRE : L); ++t) {
        const bf16* up = Zu + (size_t)t * INW;
        u32x4 u0, u1; if constexpr (NPRE > 0) { u0 = pu0[t]; u1 = pu1[t]; } else { u0 = *(const u32x4*)up; u1 = *(const u32x4*)(up + 8); }
        float u[16];
        u[0] = lo16(u0.x); u[1] = hi16(u0.x); u[2] = lo16(u0.y); u[3] = hi16(u0.y); u[4] = lo16(u0.z); u[5] = hi16(u0.z); u[6] = lo16(u0.w); u[7] = hi16(u0.w);
        u[8] = lo16(u1.x); u[9] = hi16(u1.x); u[10] = lo16(u1.y); u[11] = hi16(u1.y); u[12] = lo16(u1.z); u[13] = hi16(u1.z); u[14] = lo16(u1.w); u[15] = hi16(u1.w);
        float bur = 0.f, bui = 0.f;
#pragma unroll
        for (int c = 0; c < 16; ++c) { bur = fmaf(br[c], u[c], bur); bui = fmaf(bi[c], u[c], bui); }
        const float nr = fmaf(lr, hr, fmaf(-li, hi, bur)), ni = fmaf(lr, hi, fmaf(li, hr, bui));
        hr = nr; hi = ni;
        if constexpr (OUT) {
            float v[16];
#pragma unroll
            for (int c = 0; c < 16; ++c) v[c] = fmaf(cr[c], nr, -ci[c] * ni);
            float w8[8], w4[4], w2[2];
            { const bool h = lane & 32;
#pragma unroll
              for (int i = 0; i < 8; ++i) { const float send = h ? v[i] : v[i + 8], keep = h ? v[i + 8] : v[i]; w8[i] = keep + __shfl_xor(send, 32); } }
            { const bool h = lane & 16;
#pragma unroll
              for (int i = 0; i < 4; ++i) { const float send = h ? w8[i] : w8[i + 4], keep = h ? w8[i + 4] : w8[i]; w4[i] = keep + __shfl_xor(send, 16); } }
            { const bool h = lane & 8;
#pragma unroll
              for (int i = 0; i < 2; ++i) { const float send = h ? w4[i] : w4[i + 2], keep = h ? w4[i + 2] : w4[i]; w2[i] = keep + __shfl_xor(send, 8); } }
            float y;
            { const bool h = lane & 4; const float send = h ? w2[0] : w2[1], keep = h ? w2[1] : w2[0]; y = keep + __shfl_xor(send, 4); }
            y += __shfl_xor(y, 1); y += __shfl_xor(y, 2);
            const float ucl = bf2f(NPRE > 0 ? pcl[t] : up[cl]);
            y = fmaf(dcl, ucl, y);
            const float a = 0.7978845608028654f * (y + 0.044715f * y * y * y);
            const float th = 1.0f - 2.0f * __builtin_amdgcn_rcpf(__expf(2.0f * a) + 1.0f);
            const float z = 0.5f * y * (1.0f + th);
            if ((lane & 3) == 0) zs_out[(size_t)t * 512] = (bf16)f2bf(z);
        }
    }
}

__device__ __forceinline__ bf16x8 ld_q8(const bf16* p) { return *(const bf16x8*)p; }
template <int MODE>
__device__ __forceinline__ void swa_qtile(const LAS bf16* Ksm, const LAS bf16* Vt, int kt0, const bf16* qptr, float sink, int iq, int jmin, bf16* optr, int lane) {
    constexpr int NKT = 10, KST = 72, VST = 264;
    const int lq = lane & 15, lg = lane >> 4;
    bf16x8 qf[2];
#pragma unroll
    for (int kk = 0; kk < 2; ++kk) qf[kk] = ld_q8(qptr + 32 * kk + 8 * lg);
    f32x4 s[NKT];
#pragma unroll
    for (int kt = 0; kt < NKT; ++kt) { s[kt] = (f32x4){0.f, 0.f, 0.f, 0.f};
#pragma unroll
        for (int kk = 0; kk < 2; ++kk) { const bf16x8 kf = *(const LAS bf16x8*)(Ksm + (16 * (kt0 + kt) + lq) * KST + 32 * kk + 8 * lg); s[kt] = __builtin_amdgcn_mfma_f32_16x16x32_bf16(kf, qf[kk], s[kt], 0, 0, 0); } }
    float mx = -INFINITY;
#pragma unroll
    for (int kt = 0; kt < NKT; ++kt)
#pragma unroll
        for (int e = 0; e < 4; ++e) { const int j = 16 * (kt0 + kt) + 4 * lg + e; bool ok;
            if (MODE == 0) ok = (j > iq) && (j <= iq + 128) && (j >= jmin);
            else { const int t = lq >> 2; ok = (j < 128) ? (j >= t + 1) : (j < 132 && (j - 128) <= t); }
            const float v = ok ? s[kt][e] * 0.125f : -INFINITY; s[kt][e] = v; mx = fmaxf(mx, v); }
    mx = fmaxf(mx, __shfl_xor(mx, 16)); mx = fmaxf(mx, __shfl_xor(mx, 32)); mx = fmaxf(mx, sink);
    float sum = 0.f;
#pragma unroll
    for (int kt = 0; kt < NKT; ++kt)
#pragma unroll
        for (int e = 0; e < 4; ++e) { const float p = __expf(s[kt][e] - mx); s[kt][e] = p; sum += p; }
    sum += __shfl_xor(sum, 16); sum += __shfl_xor(sum, 32);
    const float inv = 1.0f / (sum + __expf(sink - mx));
    f32x4 o[4];
#pragma unroll
    for (int dt = 0; dt < 4; ++dt) o[dt] = (f32x4){0.f, 0.f, 0.f, 0.f};
#pragma unroll
    for (int st = 0; st < NKT / 2; ++st) {
        u32x4 pw; pw.x = pk2(s[2 * st][0] * inv, s[2 * st][1] * inv); pw.y = pk2(s[2 * st][2] * inv, s[2 * st][3] * inv); pw.z = pk2(s[2 * st + 1][0] * inv, s[2 * st + 1][1] * inv); pw.w = pk2(s[2 * st + 1][2] * inv, s[2 * st + 1][3] * inv);
        const bf16x8 pf = __builtin_bit_cast(bf16x8, pw);
#pragma unroll
        for (int dt = 0; dt < 4; ++dt) { const LAS bf16* vp = Vt + (16 * dt + lq) * VST + 16 * (kt0 + 2 * st) + 4 * lg;
            const s16x4 lo = *(const LAS s16x4*)vp, hi = *(const LAS s16x4*)(vp + 16);
            const bf16x8 vf = __builtin_shufflevector(lo, hi, 0, 1, 2, 3, 4, 5, 6, 7);
            o[dt] = __builtin_amdgcn_mfma_f32_16x16x32_bf16(vf, pf, o[dt], 0, 0, 0); } }
#pragma unroll
    for (int dt = 0; dt < 4; ++dt) { u32x2 w; w.x = pk2(o[dt][0], o[dt][1]); w.y = pk2(o[dt][2], o[dt][3]); *(u32x2*)(optr + 16 * dt + 4 * lg) = w; }
}
__device__ __forceinline__ void mem_qtile(const LAS bf16* Ksm, const LAS bf16* Vt, const bf16* qptr, bf16* optr, bool store_ok, int lane) {
    constexpr int KST = 136, VST = 264;
    const int lq = lane & 15, lg = lane >> 4;
    bf16x8 qf[4];
#pragma unroll
    for (int kk = 0; kk < 4; ++kk) qf[kk] = ld_q8(qptr + 32 * kk + 8 * lg);
    f32x4 s[16];
#pragma unroll
    for (int kt = 0; kt < 16; ++kt) { s[kt] = (f32x4){0.f, 0.f, 0.f, 0.f};
#pragma unroll
        for (int kk = 0; kk < 4; ++kk) { const bf16x8 kf = *(const LAS bf16x8*)(Ksm + (16 * kt + lq) * KST + 32 * kk + 8 * lg); s[kt] = __builtin_amdgcn_mfma_f32_16x16x32_bf16(kf, qf[kk], s[kt], 0, 0, 0); } }
    float mx = -INFINITY;
#pragma unroll
    for (int kt = 0; kt < 16; ++kt)
#pragma unroll
        for (int e = 0; e < 4; ++e) { const float v = s[kt][e] * 0.08838834764831845f; s[kt][e] = v; mx = fmaxf(mx, v); }
    mx = fmaxf(mx, __shfl_xor(mx, 16)); mx = fmaxf(mx, __shfl_xor(mx, 32));
    float sum = 0.f;
#pragma unroll
    for (int kt = 0; kt < 16; ++kt)
#pragma unroll
        for (int e = 0; e < 4; ++e) { const float p = __expf(s[kt][e] - mx); s[kt][e] = p; sum += p; }
    sum += __shfl_xor(sum, 16); sum += __shfl_xor(sum, 32);
    const float inv = 1.0f / sum;
    int xs[4], ys[4]; { const int x0 = (4 * lg) ^ ((lq >> 3) << 2);
#pragma unroll
        for (int c = 0; c < 4; ++c) { xs[c] = x0 ^ (8 * c); ys[c] = xs[c] ^ 16; } }
    f32x4 o[8];
#pragma unroll
    for (int dt = 0; dt < 8; ++dt) o[dt] = (f32x4){0.f, 0.f, 0.f, 0.f};
#pragma unroll
    for (int st = 0; st < 8; ++st) {
        u32x4 pw; pw.x = pk2(s[2 * st][0] * inv, s[2 * st][1] * inv); pw.y = pk2(s[2 * st][2] * inv, s[2 * st][3] * inv); pw.z = pk2(s[2 * st + 1][0] * inv, s[2 * st + 1][1] * inv); pw.w = pk2(s[2 * st + 1][2] * inv, s[2 * st + 1][3] * inv);
        const bf16x8 pf = __builtin_bit_cast(bf16x8, pw);
#pragma unroll
        for (int dt = 0; dt < 8; ++dt) { constexpr int dummy = 0; const int cdt = (8 * dt) & 63, hi5 = (32 * st) ^ (cdt & 32), cs = (cdt >> 3) & 3; const LAS bf16* vr = Vt + (16 * dt + lq) * VST + hi5;
            const s16x4 lo = *(const LAS s16x4*)(vr + xs[cs]), hi = *(const LAS s16x4*)(vr + ys[cs]);
            const bf16x8 vf = __builtin_shufflevector(lo, hi, 0, 1, 2, 3, 4, 5, 6, 7);
            o[dt] = __builtin_amdgcn_mfma_f32_16x16x32_bf16(vf, pf, o[dt], 0, 0, 0); } }
    if (store_ok) {
#pragma unroll
        for (int dt = 0; dt < 8; ++dt) { u32x2 w; w.x = pk2(o[dt][0], o[dt][1]); w.y = pk2(o[dt][2], o[dt][3]); *(u32x2*)(optr + 16 * dt + 4 * lg) = w; }
    }
}
template <bool SWZ>
__device__ __forceinline__ void vt_scatter(LAS bf16* Vt, int vst, int d0, int key, const u32x4 v) {
    const unsigned w[4] = {v.x, v.y, v.z, v.w};
    const int kc = SWZ ? (key ^ (((d0 >> 3) & 15) << 2)) : key;
#pragma unroll
    for (int e = 0; e < 4; ++e) { Vt[(d0 + 2 * e) * vst + kc] = (bf16)(w[e] & 0xffffu); Vt[(d0 + 2 * e + 1) * vst + kc] = (bf16)(w[e] >> 16); }
}
__device__ __forceinline__ u32x4 cvt8(const float* p) { const f32x4 a = *(const f32x4*)p, b = *(const f32x4*)(p + 4); u32x4 w; w.x = pk2(a.x, a.y); w.y = pk2(a.z, a.w); w.z = pk2(b.x, b.y); w.w = pk2(b.z, b.w); return w; }

__device__ __forceinline__ void mem_prompt_item(int i2, const bf16* Z, const bf16* MK, const bf16* MV, bf16* BR, LAS unsigned char* lds, int tid, int wave, int lane) {
    const int qc = i2 & 15, hm = (i2 >> 4) & 3, b = i2 >> 6;
    LAS bf16* Ksm = (LAS bf16*)lds; LAS bf16* Vt = (LAS bf16*)(lds + 256 * 136 * 2);
    { u32x4 kq[8], vq[8];
#pragma unroll
    for (int i = 0; i < 8; ++i) { const int cid = tid + 512 * i, key = cid >> 4, ch = cid & 15; const size_t so = (size_t)(b * NMEM + key) * 512 + hm * 128 + ch * 8; kq[i] = *(const u32x4*)(MK + so); vq[i] = *(const u32x4*)(MV + so); }
    __builtin_amdgcn_sched_barrier(0);
#pragma unroll
    for (int i = 0; i < 8; ++i) { const int cid = tid + 512 * i, key = cid >> 4, ch = cid & 15; *(LAS u32x4*)(Ksm + key * 136 + ch * 8) = kq[i]; vt_scatter<true>(Vt, 264, ch * 8, key, vq[i]); }
    __builtin_amdgcn_sched_barrier(0); }
    __syncthreads();
#pragma unroll 1
    for (int qt = 0; qt < 2; ++qt) { asm volatile("" ::: "memory"); const size_t row = (size_t)b * SEQ + qc * 256 + wave * 32 + qt * 16 + (lane & 15);
        mem_qtile(Ksm, Vt, Z + row * INW + MQO + hm * 128, BR + row * 1536 + 1024 + hm * 128, true, lane); }
    __syncthreads();
}
constexpr int MEMP_S2 = 28, MEMP_S3 = 124, MEMP_S4 = 104;
static_assert(MEMP_S2 + MEMP_S3 + MEMP_S4 == 256, "mem prompt items");

struct PRow { u32x4 qv, kvv, mv; f32x4 r0, r1, r2, r3; };
__device__ __forceinline__ PRow post_load(const bf16* Z, const float* ROPE, int r, int lane) {
    PRow p; const bf16* zr = Z + (size_t)r * INW; const int pidx = (r < MP) ? (r & (SEQ - 1)) : SEQ + ((r - MP) & 3);
    p.qv = *(const u32x4*)(zr + lane * 8); p.kvv = *(const u32x4*)(zr + KO + (lane & 31) * 8); p.mv = *(const u32x4*)(zr + MQO + lane * 8);
    const f32x4* rp = (const f32x4*)(ROPE + (size_t)(pidx * 32 + (lane & 3) * 8) * 2); p.r0 = rp[0]; p.r1 = rp[1]; p.r2 = rp[2]; p.r3 = rp[3];
    return p;
}

template <int ph, bool DRY = false>
__device__ __forceinline__ void run_phase(const Params& P, LAS unsigned char* lds) {
    const int tid = threadIdx.x, lane = tid & 63, wave = __builtin_amdgcn_readfirstlane(tid >> 6);
    const int G = gridDim.x, bid = blockIdx.x;
    const int gw = bid * 8 + wave, NGW = G * 8;
    const int gt = bid * 512 + tid, NGT = G * 512;
    unsigned char* ws = P.ws;
    float* out = P.out;
    bf16* XN = (bf16*)(ws + WS_XN); bf16* Z = (bf16*)(ws + WS_Z); bf16* BR = (bf16*)(ws + WS_BR); bf16* ZS = (bf16*)(ws + WS_ZS);
    bf16* MERGED = (bf16*)(ws + WS_MERGED); bf16* HB = (bf16*)(ws + WS_H); bf16* MEMN = (bf16*)(ws + WS_MEMN); float* KVMEM = (float*)(ws + WS_KVMEM);
    bf16* MK = (bf16*)(ws + WS_MK); bf16* MV = (bf16*)(ws + WS_MV); float* ROPE = (float*)(ws + WS_ROPE);
    float* X = out;

    {
        if constexpr (ph == 0) { if (PHM & 2048) {
            for (int pass = 0; pass < 2; ++pass) {
            if ((pass == 0) == ((bid & 1) != 0)) {
                LAS float* Cre = (LAS float*)lds; LAS float* Cim = Cre + 1024; LAS float* Bsm = Cre + 2048; LAS float* Lsm = Cre + 4096; LAS float* Msm = Cre + 8448;
                for (int it = bid; it < 256; it += G) {
                    const int lg = it >> 2, q = it & 3;
                    for (int e = tid; e < 1024; e += 512) { Cre[e] = P.in[19][(size_t)lg * 1024 + e]; Cim[e] = P.in[20][(size_t)lg * 1024 + e]; }
                    if (tid < 64) { const int p = tid, e = lg * 64 + p;
                        const double are = (double)P.in[14][e], aim = (double)P.in[15][e], dt = exp((double)P.in[16][lg]);
                        const double mag = exp(are * dt); double sn, cs; sincos_d(aim * dt, sn, cs);
                        const double lre = mag * cs, lim = mag * sn, den = are * are + aim * aim, nr = lre - 1.0, ni = lim;
                        const double gre = (nr * are + ni * aim) / den, gim = (ni * are - nr * aim) / den;
                        double qr = 1.0, qi = 0.0;
                        for (int qq = 0; qq <= 32; ++qq) { Lsm[(qq * 64 + p) * 2] = (float)qr; Lsm[(qq * 64 + p) * 2 + 1] = (float)qi; const double a = qr * lre - qi * lim, b = qr * lim + qi * lre; qr = a; qi = b; }
                        const float* bre = P.in[17] + (size_t)e * 16; const float* bim = P.in[18] + (size_t)e * 16;
                        for (int c = 0; c < 16; ++c) { const double br = bre[c], bi = bim[c]; Bsm[p * 32 + c] = (float)(gre * br - gim * bi); Bsm[p * 32 + 16 + c] = (float)(gre * bi + gim * br); } }
                    __syncthreads();
                    { const int tau = tid >> 4, cb = (tid >> 2) & 3, c2b = tid & 3; float o[4][4];
#pragma unroll
                      for (int i = 0; i < 4; ++i)
#pragma unroll
                          for (int jx = 0; jx < 4; ++jx) o[i][jx] = 0.f;
                      for (int p = 0; p < 64; ++p) { const float lr = Lsm[(tau * 64 + p) * 2], li = Lsm[(tau * 64 + p) * 2 + 1]; float clr[4], cli[4];
#pragma unroll
                          for (int i = 0; i < 4; ++i) { const float cr = Cre[(4 * cb + i) * 64 + p], ci = Cim[(4 * cb + i) * 64 + p]; clr[i] = cr * lr - ci * li; cli[i] = cr * li + ci * lr; }
#pragma unroll
                          for (int jx = 0; jx < 4; ++jx) { const float br = Bsm[p * 32 + 4 * c2b + jx], bi = Bsm[p * 32 + 16 + 4 * c2b + jx];
#pragma unroll
                              for (int i = 0; i < 4; ++i) o[i][jx] += clr[i] * br - cli[i] * bi; } }
#pragma unroll
                      for (int i = 0; i < 4; ++i)
#pragma unroll
                          for (int jx = 0; jx < 4; ++jx) Msm[(tau * 16 + 4 * cb + i) * 16 + 4 * c2b + jx] = o[i][jx]; }
                    __syncthreads();
                    bf16* bt2 = (bf16*)(ws + WS_BT2) + (size_t)lg * 512 * 640; bf16* bt1 = (bf16*)(ws + WS_BT1) + (size_t)lg * 256 * 512;
                    for (int k = 0; k < 16; ++k) { const int id = tid + 512 * k, rl = id >> 6, cc = id & 63, t = 8 * q + (rl >> 4), c = rl & 15, sp = cc >> 1, c0 = (cc & 1) * 8;
                        u32x4 w = (u32x4){0u, 0u, 0u, 0u};
                        if (sp <= t) { const LAS float* mp = Msm + ((t - sp) * 16 + c) * 16 + c0; w.x = pk2(mp[0], mp[1]); w.y = pk2(mp[2], mp[3]); w.z = pk2(mp[4], mp[5]); w.w = pk2(mp[6], mp[7]); }
                        *(u32x4*)(bt2 + (size_t)(t * 16 + c) * 640 + sp * 16 + c0) = w; }
                    for (int k = 0; k < 4; ++k) { const int id = tid + 512 * k, rl = id >> 4, cc = id & 15, t = 8 * q + (rl >> 4), c = rl & 15, isim = cc >> 3, p0 = (cc & 7) * 8; float v[8];
#pragma unroll
                        for (int e = 0; e < 8; ++e) { const int p = p0 + e; const float lr = Lsm[((t + 1) * 64 + p) * 2], li = Lsm[((t + 1) * 64 + p) * 2 + 1], cr = Cre[c * 64 + p], ci = Cim[c * 64 + p];
                            v[e] = isim ? -(cr * li + ci * lr) : (cr * lr - ci * li); }
                        u32x4 w; w.x = pk2(v[0], v[1]); w.y = pk2(v[2], v[3]); w.z = pk2(v[4], v[5]); w.w = pk2(v[6], v[7]);
                        *(u32x4*)(bt2 + (size_t)(t * 16 + c) * 640 + 512 + isim * 64 + p0) = w; }
                    for (int k = 0; k < 4; ++k) { const int id = tid + 512 * k, rl = id >> 6, cc = id & 63, sp = cc >> 1, c0 = (cc & 1) * 8, isim = q >> 1, p = (q & 1) * 32 + rl; float v[8];
                        const float lr = Lsm[((31 - sp) * 64 + p) * 2], li = Lsm[((31 - sp) * 64 + p) * 2 + 1];
#pragma unroll
                        for (int e = 0; e < 8; ++e) { const float br = Bsm[p * 32 + c0 + e], bi = Bsm[p * 32 + 16 + c0 + e]; v[e] = isim ? (lr * bi + li * br) : (lr * br - li * bi); }
                        u32x4 w; w.x = pk2(v[0], v[1]); w.y = pk2(v[2], v[3]); w.z = pk2(v[4], v[5]); w.w = pk2(v[6], v[7]);
                        *(u32x4*)(bt1 + (size_t)(isim * 64 + p) * 512 + sp * 16 + c0) = w; }
                    __syncthreads();
                }
            } else {
            LAS float* scr = (LAS float*)(lds + wave * 16640);
            for (int it = gw; it < DEPTH * TI_LAYER; it += NGW) weight_item(P, it, scr, lane);
            for (int m = gw; m < MEMROWS; m += NGW) rms_row_to_bf16(P.in[8] + (size_t)m * DM, MEMN + (size_t)m * DM, lane);
            for (int m = gw; m < MT; m += NGW) rms_row_to_bf16(m < MP ? P.in[0] + (size_t)m * DM : P.in[1] + (size_t)(m - MP) * DM, XN + (size_t)m * DM, lane);
            for (int e = gt; e < MS * DM / 4; e += NGT) ((f32x4*)(X + (size_t)MP * DM))[e] = ((const f32x4*)P.in[1])[e];
            for (int e = gt; e < NPOS * 32; e += NGT) { const int pi = e >> 5, i = e & 31; const double pos = (pi < SEQ) ? (double)pi : (double)(PAST + pi - SEQ);
                double sn, cs; sincos_d(pos * INVF[i], sn, cs); ROPE[2 * e] = (float)cs; ROPE[2 * e + 1] = (float)sn; }
            for (int e = gt; e < DEPTH * 32 * 64; e += NGT) { const int l = e >> 11, g = (e >> 6) & 31, p = e & 63;
                const double are = (double)P.in[14][e], aim = (double)P.in[15][e], dt = exp((double)P.in[16][l * 32 + g]);
                const double mag = exp(are * dt); double sn, cs; sincos_d(aim * dt, sn, cs);
                const double lre = mag * cs, lim = mag * sn, den = are * are + aim * aim, nr = lre - 1.0, ni = lim;
                const double gre = (nr * are + ni * aim) / den, gim = (ni * are - nr * aim) / den;
                double pr = lre, pi2 = lim;
                { float* lp = (float*)(ws + WS_LAMP) + ((size_t)(l * 32 + g) * 33 * 64 + p) * 2; double qr = 1.0, qi = 0.0;
                  for (int q = 0; q <= 32; ++q) { lp[(size_t)q * 128] = (float)qr; lp[(size_t)q * 128 + 1] = (float)qi; const double a = qr * lre - qi * lim, b = qr * lim + qi * lre; qr = a; qi = b; } }
#pragma unroll
                for (int q = 0; q < 5; ++q) { const double a = pr * pr - pi2 * pi2, b = 2.0 * pr * pi2; pr = a; pi2 = b; }
                float* lam = (float*)(ws + WS_LAM) + (size_t)e * 4; lam[0] = (float)lre; lam[1] = (float)lim; lam[2] = (float)pr; lam[3] = (float)pi2;
                float* bp = (float*)(ws + WS_BP) + (size_t)e * 32; const f32x4* bre = (const f32x4*)(P.in[17] + (size_t)e * 16); const f32x4* bim = (const f32x4*)(P.in[18] + (size_t)e * 16);
                const f32x4 r0 = bre[0], r1 = bre[1], r2 = bre[2], r3 = bre[3], i0 = bim[0], i1 = bim[1], i2 = bim[2], i3 = bim[3];
                __builtin_amdgcn_sched_barrier(0);
                const float brv[16] = {r0.x, r0.y, r0.z, r0.w, r1.x, r1.y, r1.z, r1.w, r2.x, r2.y, r2.z, r2.w, r3.x, r3.y, r3.z, r3.w}, biv[16] = {i0.x, i0.y, i0.z, i0.w, i1.x, i1.y, i1.z, i1.w, i2.x, i2.y, i2.z, i2.w, i3.x, i3.y, i3.z, i3.w};
#pragma unroll
                for (int c = 0; c < 16; ++c) { const double br = brv[c], bi = biv[c]; bp[c] = (float)(gre * br - gim * bi); bp[16 + c] = (float)(gre * bi + gim * br); } }
            }
            __syncthreads();
            }
            }
            return;
        }
        constexpr int l = (ph == 0) ? 0 : (ph - 1) / NPS, s = (ph == 0) ? -1 : (ph - 1) % NPS;
        const int off128 = (G == 256) ? 128 : 0;
        bf16* A2 = (bf16*)(ws + WS_A2); float* SS = (float*)(ws + WS_SS); const float* LAMP = (const float*)(ws + WS_LAMP);
        unsigned char* wb = ws + WS_W + (size_t)l * W_LAYER;
        if constexpr (s == 0 && (PHM & 1)) {
            { pg8::Gemm g{XN, (const bf16*)(wb + OFF_WIN), MT, INW, DM, DM, DM}; pg8::StaticOrder S; S.init(MT, INW, G, bid);
              pg8::EpiZ E{Z, INW, GO / 256, A2}; pg8::gemm_phase<pg8::EpiZ, pg8::StaticOrder, true, true>(lds, g, S, E); }
            { pg8::Gemm g{MEMN, (const bf16*)(wb + OFF_WMKV), MEMROWS, 1024, DM, DM, DM}; pg8::StaticOrder S; S.init(MEMROWS, 1024, G, G - 1 - bid);
              pg8::EpiF32 E{KVMEM, 1024}; pg8::gemm_phase<pg8::EpiF32, pg8::StaticOrder, true, true>(lds, g, S, E); }
        } else if constexpr (s == 1 && (PHM & 2)) {
            { pg8::Gemm g{A2, (const bf16*)(ws + WS_BT1) + (size_t)l * 32 * 256 * 512, 16384, 8192, 512, 640, 512}; pg8::GroupOrder S{G, bid, 64, 0};
              pg8::EpiS E{SS}; pg8::gemm_phase<pg8::EpiS, pg8::GroupOrder, true, true>(lds, g, S, E); }
            const float* qn = P.in[11] + l * 64; const float* kn = P.in[12] + l * 64; const float* mqn = P.in[25] + l * 128; const float* mkn = P.in[26] + l * 128;
            const bool bal = (G == 256); const int R1 = bal ? 4 * NGW : MT, gw2 = gw - 512, NGW2 = NGW - 512;
            const f32x4 gq0 = *(const f32x4*)(qn + (lane & 7) * 8), gq1 = *(const f32x4*)(qn + (lane & 7) * 8 + 4);
            const f32x4 gk0 = *(const f32x4*)(kn + (lane & 7) * 8), gk1 = *(const f32x4*)(kn + (lane & 7) * 8 + 4);
            const f32x4 gm0 = *(const f32x4*)(mqn + (lane & 15) * 8), gm1 = *(const f32x4*)(mqn + (lane & 15) * 8 + 4);
            int rr = gw, part2 = 0;
#define NEXT_ROW(dst) do { dst = -1; if (!part2 && rr >= R1) { if (bal && bid >= 64) { part2 = 1; rr = R1 + gw2; } else rr = MT; } if (rr < MT) { dst = rr; rr += part2 ? NGW2 : NGW; } } while (0)
            int rcur; NEXT_ROW(rcur);
            PRow cur; if (rcur >= 0) cur = post_load(Z, ROPE, rcur, lane);
            while (rcur >= 0) {
                int rnext; NEXT_ROW(rnext);
                PRow nxt = cur; if (rnext >= 0) nxt = post_load(Z, ROPE, rnext, lane);
                __builtin_amdgcn_sched_barrier(0);
                const int r = rcur;
                bf16* zr = Z + (size_t)r * INW; bf16* zw = DRY ? BR + (size_t)r * 1536 : zr;
                int ob; float* okp; float* ovp; bool wr_out;
                if (r < MP) { const int t = r & (SEQ - 1), b = r >> 12; wr_out = t >= SEQ - 128; ob = ((l * NB + b) * 128 + (t - (SEQ - 128))) * 128; okp = out + O_KP; ovp = out + O_VP; }
                else { const int rs = r - MP, b = rs >> 2, t = rs & 3; wr_out = true; ob = ((l * DBATCH + b) * 128 + 124 + t) * 128; okp = out + O_KS; ovp = out + O_VS; }
                const u32x4 qv = cur.qv, kvv = cur.kvv, mv = cur.mv; const f32x4 r0 = cur.r0, r1 = cur.r1, r2 = cur.r2, r3 = cur.r3;
                const float cs[8] = {r0.x, r0.z, r1.x, r1.z, r2.x, r2.z, r3.x, r3.z}, sn[8] = {r0.y, r0.w, r1.y, r1.w, r2.y, r2.w, r3.y, r3.w};
                const float gq[8] = {gq0.x, gq0.y, gq0.z, gq0.w, gq1.x, gq1.y, gq1.z, gq1.w}, gk[8] = {gk0.x, gk0.y, gk0.z, gk0.w, gk1.x, gk1.y, gk1.z, gk1.w}, gm[8] = {gm0.x, gm0.y, gm0.z, gm0.w, gm1.x, gm1.y, gm1.z, gm1.w};
                const bool hi_half = (lane & 4) != 0;
                {
                    float x[8] = {lo16(qv.x), hi16(qv.x), lo16(qv.y), hi16(qv.y), lo16(qv.z), hi16(qv.z), lo16(qv.w), hi16(qv.w)}; float ss = 0.f;
#pragma unroll
                    for (int j = 0; j < 8; ++j) ss = fmaf(x[j], x[j], ss);
                    ss += __shfl_xor(ss, 1); ss += __shfl_xor(ss, 2); ss += __shfl_xor(ss, 4);
                    const float rs = 1.0f / sqrtf(ss * (1.f / 64.f) + EPS); float o[8];
#pragma unroll
                    for (int j = 0; j < 8; ++j) { const float vn = x[j] * rs * gq[j]; const float pt = __shfl_xor(vn, 4); o[j] = hi_half ? vn * cs[j] + pt * sn[j] : vn * cs[j] - pt * sn[j]; }
                    u32x4 w; w.x = pk2(o[0], o[1]); w.y = pk2(o[2], o[3]); w.z = pk2(o[4], o[5]); w.w = pk2(o[6], o[7]); *(u32x4*)(zw + lane * 8) = w; }
                {
                    float x[8] = {lo16(kvv.x), hi16(kvv.x), lo16(kvv.y), hi16(kvv.y), lo16(kvv.z), hi16(kvv.z), lo16(kvv.w), hi16(kvv.w)}; float ss = 0.f;
#pragma unroll
                    for (int j = 0; j < 8; ++j) ss = fmaf(x[j], x[j], ss);
                    ss += __shfl_xor(ss, 1); ss += __shfl_xor(ss, 2); ss += __shfl_xor(ss, 4);
                    const float rs = 1.0f / sqrtf(ss * (1.f / 64.f) + EPS); float o[8];
#pragma unroll
                    for (int j = 0; j < 8; ++j) { const float vn = x[j] * rs * gk[j]; const float pt = __shfl_xor(vn, 4); o[j] = hi_half ? vn * cs[j] + pt * sn[j] : vn * cs[j] - pt * sn[j]; }
                    if (lane < 16) { u32x4 w; w.x = pk2(o[0], o[1]); w.y = pk2(o[2], o[3]); w.z = pk2(o[4], o[5]); w.w = pk2(o[6], o[7]); *(u32x4*)(zw + KO + lane * 8) = w;
                        if (wr_out) { *(f32x4*)(okp + (size_t)ob + lane * 8) = (f32x4){o[0], o[1], o[2], o[3]}; *(f32x4*)(okp + (size_t)ob + lane * 8 + 4) = (f32x4){o[4], o[5], o[6], o[7]}; } }
                    else if (lane < 32 && wr_out) { *(f32x4*)(ovp + (size_t)ob + (lane - 16) * 8) = (f32x4){x[0], x[1], x[2], x[3]}; *(f32x4*)(ovp + (size_t)ob + (lane - 16) * 8 + 4) = (f32x4){x[4], x[5], x[6], x[7]}; } }
                {
                    float x[8] = {lo16(mv.x), hi16(mv.x), lo16(mv.y), hi16(mv.y), lo16(mv.z), hi16(mv.z), lo16(mv.w), hi16(mv.w)}; float ss = 0.f;
#pragma unroll
                    for (int j = 0; j < 8; ++j) ss = fmaf(x[j], x[j], ss);
                    ss += __shfl_xor(ss, 1); ss += __shfl_xor(ss, 2); ss += __shfl_xor(ss, 4); ss += __shfl_xor(ss, 8);
                    const float rs = 1.0f / sqrtf(ss * (1.f / 128.f) + EPS);
                    u32x4 w; w.x = pk2(x[0] * rs * gm[0], x[1] * rs * gm[1]); w.y = pk2(x[2] * rs * gm[2], x[3] * rs * gm[3]); w.z = pk2(x[4] * rs * gm[4], x[5] * rs * gm[5]); w.w = pk2(x[6] * rs * gm[6], x[7] * rs * gm[7]);
                    *(u32x4*)(zw + (DRY ? 640 : MQO) + lane * 8) = w; }
                cur = nxt; rcur = rnext;
            }
#undef NEXT_ROW
            for (int mr = (bal ? (bid >= 64 ? gw - 512 : MEMROWS) : gw); mr < MEMROWS; mr += (bal ? NGW - 512 : NGW)) {
                const float* src = KVMEM + (size_t)mr * 1024; float* ok = out + O_MKP + ((size_t)l * MEMROWS + mr) * 512; float* ov = out + O_MVP + ((size_t)l * MEMROWS + mr) * 512;
                float kx[8], vx[8];
#pragma unroll
                for (int i = 0; i < 8; ++i) { kx[i] = src[i * 64 + lane]; vx[i] = src[512 + i * 64 + lane]; }
                __builtin_amdgcn_sched_barrier(0);
#pragma unroll
                for (int hm = 0; hm < 4; ++hm) { const float a = kx[2 * hm], b2 = kx[2 * hm + 1];
                    const float ss = wave_sum(a * a + b2 * b2); const float rs = 1.0f / sqrtf(ss * (1.f / 128.f) + EPS);
                    const float ka = a * rs * mkn[lane], kb = b2 * rs * mkn[64 + lane];
                    ok[hm * 128 + lane] = ka; ok[hm * 128 + 64 + lane] = kb; MK[(size_t)mr * 512 + hm * 128 + lane] = (bf16)f2bf(ka); MK[(size_t)mr * 512 + hm * 128 + 64 + lane] = (bf16)f2bf(kb); }
#pragma unroll
                for (int i = 0; i < 8; ++i) { ov[i * 64 + lane] = vx[i]; MV[(size_t)mr * 512 + i * 64 + lane] = (bf16)f2bf(vx[i]); }
            }
            { const f32x4* ck = (const f32x4*)(P.in[2] + (size_t)l * DBATCH * 128 * 128); const f32x4* cv = (const f32x4*)(P.in[3] + (size_t)l * DBATCH * 128 * 128);
              f32x4* dk = (f32x4*)(out + O_KS + (size_t)l * DBATCH * 128 * 128); f32x4* dv = (f32x4*)(out + O_VS + (size_t)l * DBATCH * 128 * 128);
              for (int e = gt; e < DBATCH * 124 * 32; e += 2 * NGT) { const int e2 = e + NGT; const bool ok2 = e2 < DBATCH * 124 * 32; const int b = e / (124 * 32), rem = e % (124 * 32), b2 = ok2 ? e2 / (124 * 32) : b, rem2 = ok2 ? e2 % (124 * 32) : rem;
                  const f32x4 k0 = ck[b * 4096 + 128 + rem], v0 = cv[b * 4096 + 128 + rem], k1 = ck[b2 * 4096 + 128 + rem2], v1 = cv[b2 * 4096 + 128 + rem2];
                  __builtin_amdgcn_sched_barrier(0);
                  dk[b * 4096 + rem] = k0; dv[b * 4096 + rem] = v0; if (ok2) { dk[b2 * 4096 + rem2] = k1; dv[b2 * 4096 + rem2] = v1; } } }
        } else if constexpr (s == 2 && (PHM & 4)) {
            const bool balI = (G == 256); int nsamp = 0, js0 = 0, js1 = 0, js2 = 0;
            if (balI) { if (bid < 16) { nsamp = 1; js0 = 240 + bid; } else if (bid < 60) { nsamp = 3; js0 = bid - 16; js1 = 240 + bid; js2 = (bid < 44) ? 196 + bid : 452 + bid; }
                        else if (bid < 228) { nsamp = 2; js0 = bid - 16; js1 = 240 + bid; } else { nsamp = 1; js0 = 240 + bid; } }
            const int nk_main = ((balI ? 1296 : 1296 + 512) - 1 - bid) / G + 1, nk_items = nk_main + nsamp;
            for (int kk = 0; kk < nk_items; ++kk) { const int slot = (bid & 1) ? (nk_items - 1 - kk) : kk; int it;
                if (slot < nk_main) it = bid + slot * G; else { const int q = slot - nk_main; it = 1296 + (q == 0 ? js0 : (q == 1 ? js1 : js2)); }
              for (int rep = 0; rep < ((it < 1280) ? REP_ATT : REP_SSM2); ++rep) { asm volatile("" ::: "memory");
                if (it < 256) { if (ITM & 1) {
                    const bool xa = (G == 256);
                    const int kvh = xa ? (it & 1) : (it & 1), blk = xa ? (it >> 3) : ((it >> 1) & 31), b = xa ? ((it >> 1) & 3) : (it >> 6);
                    LAS bf16* Ksm = (LAS bf16*)lds; LAS bf16* Vt = (LAS bf16*)(lds + 256 * 72 * 2);
                    { u32x4 kq[4], vq[4];
#pragma unroll
                    for (int i = 0; i < 4; ++i) { const int cid = tid + 512 * i, key = cid >> 3, ch = cid & 7; const int trow = (blk - 1) * 128 + key;
                        kq[i] = (u32x4){0u, 0u, 0u, 0u}; vq[i] = kq[i];
                        if (trow >= 0) { const bf16* zr = Z + (size_t)(b * SEQ + trow) * INW; kq[i] = *(const u32x4*)(zr + KO + kvh * 64 + ch * 8); vq[i] = *(const u32x4*)(zr + VO + kvh * 64 + ch * 8); } }
                    __builtin_amdgcn_sched_barrier(0);
#pragma unroll
                    for (int i = 0; i < 4; ++i) { const int cid = tid + 512 * i, key = cid >> 3, ch = cid & 7;
                        *(LAS u32x4*)(Ksm + key * 72 + ch * 8) = kq[i]; vt_scatter<false>(Vt, 264, ch * 8, key, vq[i]); }
                    __builtin_amdgcn_sched_barrier(0); }
                    __syncthreads();
                    const int gq = wave >> 1, qh = wave & 1, hq = kvh * 4 + gq; const float sink = P.in[13][l * 8 + hq];
#pragma unroll 1
                    for (int qt = 0; qt < 4; ++qt) { asm volatile("" ::: "memory"); const int i0 = qh * 64 + qt * 16; const size_t row = (size_t)b * SEQ + blk * 128 + i0 + (lane & 15);
                        swa_qtile<0>(Ksm, Vt, (i0 >> 4) < 6 ? (i0 >> 4) : 6, Z + row * INW + hq * 64, sink, i0 + (lane & 15), blk > 0 ? 0 : 128, BR + row * 1536 + hq * 64, lane); }
                    __syncthreads();
                } } else if (it < 512) { if (ITM & 2) {
                    const int i2 = it - 256, kvh = i2 & 1, b = i2 >> 1;
                    LAS bf16* Ksm = (LAS bf16*)lds; LAS bf16* Vt = (LAS bf16*)(lds + 256 * 72 * 2);
                    { f32x4 kf[3][2], vf[3][2]; u32x4 kz[3], vz[3];
#pragma unroll
                    for (int i = 0; i < 3; ++i) { const int cid = tid + 512 * i, key = cid >> 3, ch = cid & 7;
                        kf[i][0] = kf[i][1] = vf[i][0] = vf[i][1] = (f32x4){0.f, 0.f, 0.f, 0.f}; kz[i] = vz[i] = (u32x4){0u, 0u, 0u, 0u};
                        if (key < 128) { const size_t so = ((((size_t)l * DBATCH + b) * 128 + key) * 2 + kvh) * 64 + ch * 8;
                            kf[i][0] = *(const f32x4*)(P.in[2] + so); kf[i][1] = *(const f32x4*)(P.in[2] + so + 4); vf[i][0] = *(const f32x4*)(P.in[3] + so); vf[i][1] = *(const f32x4*)(P.in[3] + so + 4); }
                        else if (key < 132) { const bf16* zr = Z + (size_t)(MP + b * 4 + key - 128) * INW; kz[i] = *(const u32x4*)(zr + KO + kvh * 64 + ch * 8); vz[i] = *(const u32x4*)(zr + VO + kvh * 64 + ch * 8); } }
                    __builtin_amdgcn_sched_barrier(0);
#pragma unroll
                    for (int i = 0; i < 3; ++i) { const int cid = tid + 512 * i; if (cid < 1280) { const int key = cid >> 3, ch = cid & 7;
                        u32x4 kv = kz[i], vv = vz[i];
                        if (key < 128) { kv.x = pk2(kf[i][0].x, kf[i][0].y); kv.y = pk2(kf[i][0].z, kf[i][0].w); kv.z = pk2(kf[i][1].x, kf[i][1].y); kv.w = pk2(kf[i][1].z, kf[i][1].w);
                            vv.x = pk2(vf[i][0].x, vf[i][0].y); vv.y = pk2(vf[i][0].z, vf[i][0].w); vv.z = pk2(vf[i][1].x, vf[i][1].y); vv.w = pk2(vf[i][1].z, vf[i][1].w); }
                        *(LAS u32x4*)(Ksm + key * 72 + ch * 8) = kv; vt_scatter<false>(Vt, 264, ch * 8, key, vv); } }
                    __builtin_amdgcn_sched_barrier(0); }
                    __syncthreads();
                    if (wave == 0) { const int lq = lane & 15, t = lq >> 2, gq = lq & 3, hq = kvh * 4 + gq; const size_t row = (size_t)MP + b * 4 + t;
                        swa_qtile<1>(Ksm, Vt, 0, Z + row * INW + hq * 64, P.in[13][l * 8 + hq], 0, 0, BR + row * 1536 + hq * 64, lane); }
                    __syncthreads();
                } } else if (it < 768) { if (ITM & 4) {
                    if (it - 512 >= 256 - MEMP_S2) mem_prompt_item(it - 512 - (256 - MEMP_S2), Z, MK, MV, BR, lds, tid, wave, lane);
                } } else if (it < 1280) { if (ITM & 8) {
                    const int i2 = it - 768, hm = i2 & 3, b = i2 >> 2;
                    LAS bf16* Ksm = (LAS bf16*)lds; LAS bf16* Vt = (LAS bf16*)(lds + 256 * 136 * 2);
#pragma unroll
                    for (int hb = 0; hb < 2; ++hb) { f32x4 kf[4][2], vf[4][2];
#pragma unroll
                        for (int i = 0; i < 4; ++i) { const int cid = tid + 512 * (4 * hb + i), key = cid >> 4, ch = cid & 15; const size_t so = ((((size_t)l * DBATCH + b) * NMEM + key) * 4 + hm) * 128 + ch * 8;
                            kf[i][0] = *(const f32x4*)(P.in[6] + so); kf[i][1] = *(const f32x4*)(P.in[6] + so + 4); vf[i][0] = *(const f32x4*)(P.in[7] + so); vf[i][1] = *(const f32x4*)(P.in[7] + so + 4); }
                        __builtin_amdgcn_sched_barrier(0);
#pragma unroll
                        for (int i = 0; i < 4; ++i) { const int cid = tid + 512 * (4 * hb + i), key = cid >> 4, ch = cid & 15; u32x4 kv, vv;
                            kv.x = pk2(kf[i][0].x, kf[i][0].y); kv.y = pk2(kf[i][0].z, kf[i][0].w); kv.z = pk2(kf[i][1].x, kf[i][1].y); kv.w = pk2(kf[i][1].z, kf[i][1].w);
                            vv.x = pk2(vf[i][0].x, vf[i][0].y); vv.y = pk2(vf[i][0].z, vf[i][0].w); vv.z = pk2(vf[i][1].x, vf[i][1].y); vv.w = pk2(vf[i][1].z, vf[i][1].w);
                            *(LAS u32x4*)(Ksm + key * 136 + ch * 8) = kv; vt_scatter<true>(Vt, 264, ch * 8, key, vv); }
                        __builtin_amdgcn_sched_barrier(0); }
                    __syncthreads();
                    if (wave == 0) { const int lq = lane & 15; const size_t row = (size_t)MP + b * 4 + (lq & 3);
                        mem_qtile(Ksm, Vt, Z + row * INW + MQO + hm * 128, BR + row * 1536 + 1024 + hm * 128, lq < 4, lane); }
                    __syncthreads();
                } } else if (it < 1296) { if (ITM & 16) {
                    const int wi = (it - 1280) * 8 + wave, g = wi & 31, b = wi >> 5;
                    const float l32r = LAMP[((size_t)(l * 32 + g) * 33 + 32) * 128 + lane * 2], l32i = LAMP[((size_t)(l * 32 + g) * 33 + 32) * 128 + lane * 2 + 1];
                    const float* ssp = SS + (size_t)(g * 512 + b * 128) * 128 + lane; bf16* hs = A2 + (size_t)(g * 512 + b * 128) * 640 + 512 + lane;
                    float hr = 0.f, hi = 0.f;
#pragma unroll 1
                    for (int j0 = 0; j0 < 128; j0 += 16) { float sr[16], si[16];
#pragma unroll
                        for (int j = 0; j < 16; ++j) { sr[j] = ssp[(size_t)(j0 + j) * 128]; si[j] = ssp[(size_t)(j0 + j) * 128 + 64]; }
                        __builtin_amdgcn_sched_barrier(0);
#pragma unroll
                        for (int j = 0; j < 16; ++j) { hs[(size_t)(j0 + j) * 640] = (bf16)f2bf(hr); hs[(size_t)(j0 + j) * 640 + 64] = (bf16)f2bf(hi);
                            const float nr = fmaf(l32r, hr, fmaf(-l32i, hi, sr[j])), ni = fmaf(l32r, hi, fmaf(l32i, hr, si[j])); hr = nr; hi = ni; }
                        __builtin_amdgcn_sched_barrier(0); }
                    const size_t oo = (((size_t)l * NB + b) * 32 + g) * 64 + lane; out[O_HRP + oo] = hr; out[O_HIP + oo] = hi;
                } } else { if (ITM & 16) {
                    const int wi = (it - 1296) * 8 + wave, g = wi & 31, b = wi >> 5; const size_t row0 = (size_t)MP + b * 4;
                    const int e = (l * 32 + g) * 64 + lane; const f32x4 lam = *(const f32x4*)((const float*)(ws + WS_LAM) + (size_t)e * 4);
                    const size_t so = (((size_t)l * DBATCH + b) * 32 + g) * 64 + lane; float hr = P.in[4][so], hi = P.in[5][so];
                    float br[16], bi[16], cr[16], ci[16];
                    { const f32x4* bp = (const f32x4*)((const float*)(ws + WS_BP) + (size_t)e * 32);
#pragma unroll
                      for (int q = 0; q < 4; ++q) { const f32x4 a = bp[q], b4 = bp[4 + q]; br[4 * q] = a.x; br[4 * q + 1] = a.y; br[4 * q + 2] = a.z; br[4 * q + 3] = a.w; bi[4 * q] = b4.x; bi[4 * q + 1] = b4.y; bi[4 * q + 2] = b4.z; bi[4 * q + 3] = b4.w; } }
                    { const float* cre = P.in[19] + ((size_t)(l * 32 + g) * 16) * 64 + lane; const float* cim = P.in[20] + ((size_t)(l * 32 + g) * 16) * 64 + lane;
#pragma unroll
                      for (int q = 0; q < 16; ++q) { cr[q] = cre[q * 64]; ci[q] = cim[q * 64]; } }
                    const float dcl = P.in[21][l * 512 + g * 16 + (lane >> 2)];
                    ssm_run<true, 4>(Z + row0 * INW + UO + g * 16, 4, lam.x, lam.y, br, bi, hr, hi, cr, ci, dcl, ZS + row0 * 512 + g * 16 + (lane >> 2), lane);
                    out[O_HRS + so] = hr; out[O_HIS + so] = hi;
                } }
              }
            }
        } else if constexpr (s == 3 && (PHM & 8)) {
            pg8::Gemm g{A2, (const bf16*)(ws + WS_BT2) + (size_t)l * 32 * 512 * 640, 16384, 16384, 640, 640, 640}; pg8::GroupOrder S{G, bid, 128, 1};
            pg8::EpiY E{A2, P.in[21] + l * 512, ZS}; pg8::gemm_phase<pg8::EpiY, pg8::GroupOrder, true, true>(lds, g, S, E);
            { pg8::Gemm g2{ZS, (const bf16*)(wb + OFF_WGLU), MT, 512, 512, 512, 512}; pg8::RangeOrder S2{G, bid - off128, 64, 2, 2};
              pg8::EpiGlu E2{ZS, BR}; pg8::gemm_phase<pg8::EpiGlu, pg8::RangeOrder, true, true>(lds, g2, S2, E2); }
            if (G == 256 && bid >= 256 - MEMP_S3) mem_prompt_item(MEMP_S2 + bid - (256 - MEMP_S3), Z, MK, MV, BR, lds, tid, wave, lane);
            else if (G != 256) { for (int i2 = MEMP_S2 + bid; i2 < MEMP_S2 + MEMP_S3; i2 += G) mem_prompt_item(i2, Z, MK, MV, BR, lds, tid, wave, lane); }
        } else if constexpr (s == 4 && (PHM & 16)) {
            { pg8::Gemm g{ZS, (const bf16*)(wb + OFF_WGLU), MP, 512, 512, 512, 512}; pg8::StaticOrder S; S.init(MP, 512, G, bid);
              pg8::EpiGlu E{ZS, BR}; pg8::gemm_phase<pg8::EpiGlu, pg8::StaticOrder, true, true>(lds, g, S, E); }
            { pg8::Gemm g{BR, (const bf16*)(wb + OFF_WBR), MT, DM, 512, 1536, 1536}; pg8::TailOrder S{bid - off128, 3, 1024, G};
              pg8::EpiGatePart E{Z, (float*)(ws + WS_PART)}; pg8::gemm_phase<pg8::EpiGatePart, pg8::TailOrder, true, true>(lds, g, S, E); }
            if (G == 256 && bid >= 256 - MEMP_S4) mem_prompt_item(MEMP_S2 + MEMP_S3 + bid - (256 - MEMP_S4), Z, MK, MV, BR, lds, tid, wave, lane);
            else if (G != 256) { for (int i2 = MEMP_S2 + MEMP_S3 + bid; i2 < 256; i2 += G) mem_prompt_item(i2, Z, MK, MV, BR, lds, tid, wave, lane); }
        } else if constexpr (s == 5 && (PHM & 32)) {
            pg8::Gemm g{BR, (const bf16*)(wb + OFF_WBR), MP, DM, 1536, 1536, 1536}; pg8::StaticOrder S; S.init(MP, DM, G, bid);
            pg8::EpiMerge E{Z, MERGED}; pg8::gemm_phase<pg8::EpiMerge, pg8::StaticOrder, true, true>(lds, g, S, E);
            for (int e = gt; e < MS * DM / 4; e += NGT) { const f32x4* pp = (const f32x4*)(ws + WS_PART) + e; const f32x4 v = pp[0] + pp[MS * DM / 4] + pp[2 * (MS * DM / 4)];
                u32x2 w; w.x = pk2(v.x, v.y); w.y = pk2(v.z, v.w); *(u32x2*)(MERGED + (size_t)MP * DM + (size_t)e * 4) = w; }
        } else if constexpr (s == 6 && (PHM & 64)) {
            { pg8::Gemm g{MERGED, (const bf16*)(wb + OFF_WOUT), MP, DM, DM, DM, DM}; pg8::StaticOrder S; S.init(MP, DM, G, bid);
              pg8::EpiRes E{l == 0 ? P.in[0] : X, l == 0 ? P.in[1] : X + (size_t)MP * DM, X, DM}; pg8::gemm_phase<pg8::EpiRes, pg8::StaticOrder, true, true>(lds, g, S, E); }
            { pg8::Gemm g{MERGED, (const bf16*)(wb + OFF_WOUT), MT, DM, 128, DM, DM}; pg8::TailOrder S{G - 1 - bid, 8, 256, G};
              pg8::EpiPart E{(float*)(ws + WS_PART), 256}; pg8::gemm_phase<pg8::EpiPart, pg8::TailOrder, true, true>(lds, g, S, E); }
        } else if constexpr ((s == 7 || s == 10) && (PHM & 128)) {
            constexpr bool last_ph = (ph == NPHASE - 1);
            for (int m = (last_ph ? MP + gw : gw); m < MT; m += NGW) { if (m < MP) rms_row_to_bf16(X + (size_t)m * DM, XN + (size_t)m * DM, lane);
                else rms_row_to_bf16(X + (size_t)m * DM, XN + (size_t)m * DM, lane, (const float*)(ws + WS_PART) + (size_t)(m - MP) * DM, s == 7 ? 8 : 11, X + (size_t)m * DM, !last_ph); }
        } else if constexpr (s == 8 && (PHM & 256)) {
            pg8::Gemm g{XN, (const bf16*)(wb + OFF_WUP), MT, 2 * DFF, DM, DM, DM}; pg8::StaticOrder S; S.init(MT, 2 * DFF, G, bid);
            pg8::EpiSwiglu E{HB}; pg8::gemm_phase<pg8::EpiSwiglu, pg8::StaticOrder, true, true>(lds, g, S, E);
        } else if constexpr (s == 9 && (PHM & 512)) {
            { pg8::Gemm g{HB, (const bf16*)(wb + OFF_WDN), MP, DM, DFF, DFF, DFF}; pg8::StaticOrder S; S.init(MP, DM, G, bid);
              pg8::EpiRes E{X, X + (size_t)MP * DM, DRY ? (float*)(ws + WS_MERGED) : X, DM}; pg8::gemm_phase<pg8::EpiRes, pg8::StaticOrder, true, true>(lds, g, S, E); }
            { pg8::Gemm g{HB, (const bf16*)(wb + OFF_WDN), MT, DM, 256, DFF, DFF}; pg8::TailOrder S{G - 1 - bid, 11, 512, G};
              pg8::EpiPart E{(float*)(ws + WS_PART), 512}; pg8::gemm_phase<pg8::EpiPart, pg8::TailOrder, true, true>(lds, g, S, E); }
        }
    }
}

#define XB_TMO      128
#define XB_XCNT(j)  (256  + 64 * (j))
#define XB_XSUB(j)  (1280 + 64 * (j))
#define XB_XGEN(j)  (2304 + 64 * (j))
#define XB_TOP      3328
#define XB_TOPGEN   3392
#define XCD_BAR_WORDS 3456
#define XB_SPIN_CAP (1u << 18)
__device__ __forceinline__ unsigned xb_ld(unsigned* p)              { return __hip_atomic_load(p, __ATOMIC_RELAXED, __HIP_MEMORY_SCOPE_AGENT); }
__device__ __forceinline__ unsigned xb_add(unsigned* p, unsigned v) { return __hip_atomic_fetch_add(p, v, __ATOMIC_RELAXED, __HIP_MEMORY_SCOPE_AGENT); }
__device__ __forceinline__ unsigned xb_xcc_id() { return (unsigned)__builtin_amdgcn_s_getreg((3 << 11) | 20) & 0xFu; }
#define XB_SPIN(cond, bar) do { unsigned _sp = 0; while (cond) { __builtin_amdgcn_s_sleep(1); \
    if ((++_sp & 255u) == 0u) { if (xb_ld(&(bar)[XB_TMO])) break; if (_sp > XB_SPIN_CAP) { atomicAdd(&(bar)[XB_TMO], 1u); break; } } } } while (0)
struct XcdBarrier { unsigned* bar; unsigned x; volatile LAS unsigned* st; };
__device__ __forceinline__ XcdBarrier xcd_barrier_post(unsigned* bar, volatile LAS unsigned* st) {
    XcdBarrier b; b.bar = bar; b.x = xb_xcc_id(); b.st = st;
    if (threadIdx.x == 0) (void)xb_add(&bar[XB_XCNT(b.x)], 1u);
    return b;
}
__device__ __forceinline__ void xcd_barrier_complete(unsigned* bar, unsigned x, unsigned& nloc, unsigned& nx) {
    const unsigned G = gridDim.x * gridDim.y * gridDim.z;
    unsigned sum, cnt, mine, sp = 0u;
    for (;;) {
        sum = 0u; cnt = 0u; mine = 0u;
#pragma unroll
        for (unsigned j = 0; j < 16; ++j) { const unsigned c = xb_ld(&bar[XB_XCNT(j)]); sum += c; cnt += (c > 0u) ? 1u : 0u; mine = (j == x) ? c : mine; }
        if (sum == G) break;
        __builtin_amdgcn_s_sleep(1);
        if ((++sp & 255u) == 0u) { if (xb_ld(&bar[XB_TMO])) break; if (sp > XB_SPIN_CAP) { atomicAdd(&bar[XB_TMO], 1u); break; } }
    }
    nloc = mine > 0u ? mine : 1u; nx = cnt > 0u ? cnt : 1u;
}
__device__ __forceinline__ void xcd_barrier(const XcdBarrier& b) {
    asm volatile("s_waitcnt vmcnt(0)" ::: "memory");
    __syncthreads();
    if (threadIdx.x == 0) {
        unsigned* bar = b.bar;
        __builtin_amdgcn_s_waitcnt(0);
        unsigned nloc = b.st[0], nx = b.st[1];
        if (nloc == 0u) { xcd_barrier_complete(bar, b.x, nloc, nx); b.st[0] = nloc; b.st[1] = nx; }
        const unsigned old = xb_add(&bar[XB_XSUB(b.x)], 1u);
        const unsigned gen = old / nloc;
        if (old + 1u == (gen + 1u) * nloc) {
            __builtin_amdgcn_fence(__ATOMIC_RELEASE, "agent");
            asm volatile("s_waitcnt vmcnt(0)" ::: "memory");
            const unsigned og = xb_add(&bar[XB_TOP], 1u);
            const unsigned tg = og / nx;
            if (og + 1u == (tg + 1u) * nx) xb_add(&bar[XB_TOPGEN], 1u);
            else XB_SPIN(xb_ld(&bar[XB_TOPGEN]) == tg, bar);
            __builtin_amdgcn_fence(__ATOMIC_ACQUIRE, "agent");
            xb_add(&bar[XB_XGEN(b.x)], 1u);
            asm volatile("s_waitcnt vmcnt(0)" ::: "memory");
        } else {
            XB_SPIN(xb_ld(&bar[XB_XGEN(b.x)]) == gen, bar);
            __builtin_amdgcn_fence(__ATOMIC_ACQUIRE, "agent");
            asm volatile("s_waitcnt vmcnt(0)" ::: "memory");
        }
    }
    __syncthreads();
}
constexpr int LDS_BAR_OFF = 147456 - 64;

__global__ void __launch_bounds__(512, 2) fwd_kernel(Params P) {
    extern __shared__ __attribute__((aligned(16))) unsigned char lds_raw[];
    LAS unsigned char* lds = (LAS unsigned char*)lds_raw;
    volatile LAS unsigned* bst = (volatile LAS unsigned*)(lds + LDS_BAR_OFF);
    if (threadIdx.x < 2) bst[threadIdx.x] = 0u;
    __syncthreads();
    XcdBarrier xbar; xbar.bar = (unsigned*)P.ws; xbar.x = 0; xbar.st = bst;
    if (P.ph_hi - P.ph_lo > 1) xbar = xcd_barrier_post((unsigned*)P.ws, bst);
    if (P.ph_hi < 0) cg::this_grid().sync();
#define RUNPH(I) if (P.ph_lo <= (I) && (I) < P.ph_hi) { if ((I) > P.ph_lo) xcd_barrier(xbar); run_phase<(I)>(P, lds); }
    RUNPH(0) RUNPH(1) RUNPH(2) RUNPH(3) RUNPH(4) RUNPH(5) RUNPH(6) RUNPH(7) RUNPH(8) RUNPH(9)
    RUNPH(10) RUNPH(11) RUNPH(12) RUNPH(13) RUNPH(14) RUNPH(15) RUNPH(16) RUNPH(17) RUNPH(18) RUNPH(19)
    RUNPH(20) RUNPH(21) RUNPH(22)
    static_assert(NPHASE == 23, "phase list");
#undef RUNPH
}

extern "C" void kernel_launch(void* const* d_in, const int* in_sizes, int n_in, void* d_out, int out_size, void* d_ws, size_t ws_size, hipStream_t stream) {
    static int grid = 0;
    if (grid == 0) {
        if (n_in != 32 || out_size != (int)O_END || ws_size < WS_END) { fprintf(stderr, "kernel_launch: unexpected shapes: n_in %d out %d ws %zu\n", n_in, out_size, ws_size); grid = -1; return; }
        int dev = 0, cus = 0, per_cu = 0;
        hipGetDevice(&dev); hipDeviceGetAttribute(&cus, hipDeviceAttributeMultiprocessorCount, dev);
        if (hipFuncSetAttribute((const void*)fwd_kernel, hipFuncAttributeMaxDynamicSharedMemorySize, LDS_BYTES) != hipSuccess) { fprintf(stderr, "kernel_launch: hipFuncSetAttribute failed\n"); grid = -1; return; }
        if (hipOccupancyMaxActiveBlocksPerMultiprocessor(&per_cu, (const void*)fwd_kernel, 512, LDS_BYTES) != hipSuccess || per_cu < 1) { fprintf(stderr, "kernel_launch: occupancy query says %d\n", per_cu); per_cu = 1; }
        (void)hipGetLastError();
        grid = cus * 1;
        if (grid <= 0) grid = 256;
    }
    if (grid < 0) return;
    Params p{};
    for (int i = 0; i < 32; ++i) p.in[i] = (const float*)d_in[i];
    p.out = (float*)d_out; p.ws = (unsigned char*)d_ws;
#if ONE_LAUNCH
    p.ph_lo = 0; p.ph_hi = NPHASE;
    if (hipMemsetAsync(d_ws, 0, 16384, stream) != hipSuccess) { fprintf(stderr, "kernel_launch: memset of barrier words failed\n"); return; }
    void* args[] = {&p};
    hipError_t e = hipLaunchCooperativeKernel((const void*)fwd_kernel, dim3(grid), dim3(512), args, LDS_BYTES, stream);
    if (e != hipSuccess) fprintf(stderr, "cooperative launch failed: %s (grid %d)\n", hipGetErrorString(e), grid);
#else
    for (int ph = 0; ph < NPHASE; ++ph) { p.ph_lo = ph; p.ph_hi = ph + 1; hipLaunchKernelGGL(fwd_kernel, dim3(grid), dim3(512), LDS_BYTES, stream, p); }
#endif
}
```

```cpp
#include <hip/hip_runtime.h>
#include <hip/hip_cooperative_groups.h>
#include <cstdio>
#include <cstdint>
namespace cg = cooperative_groups;

#ifndef PHM
#define PHM 4095
#endif
#ifndef ITM
#define ITM 31
#endif
#ifndef REP_ATT
#define REP_ATT 1
#endif
#ifndef REP_SSM1
#define REP_SSM1 1
#endif
#ifndef REP_SSM2
#define REP_SSM2 1
#endif
#ifndef ONE_LAUNCH
#define ONE_LAUNCH 1
#endif

#define LAS __attribute__((address_space(3)))
typedef unsigned short bf16;
typedef short bf16x8 __attribute__((ext_vector_type(8)));
typedef short s16x4 __attribute__((ext_vector_type(4)));
typedef float f32x4 __attribute__((ext_vector_type(4)));
typedef unsigned u32x4 __attribute__((ext_vector_type(4)));
typedef unsigned u32x2 __attribute__((ext_vector_type(2)));

constexpr int DM = 1024, NB = 4, SEQ = 4096, DEPTH = 2, DBATCH = 128, DSEQ = 4;
constexpr int MP = NB * SEQ, MS = DBATCH * DSEQ, MT = MP + MS;
constexpr int INW = 4864, KO = 512, VO = 640, UO = 768, MQO = 1280, GO = 1792;
constexpr int DFF = 2816, NMEM = 256, MEMROWS = NB * NMEM;
constexpr float EPS = 1e-6f;
constexpr int NPOS = SEQ + DSEQ;
constexpr int PAST = 16384;

constexpr size_t O_YP = 0, O_YS = O_YP + (size_t)MP * DM, O_KP = O_YS + (size_t)MS * DM, O_VP = O_KP + 2 * 4 * 128 * 128,
                 O_HRP = O_VP + 2 * 4 * 128 * 128, O_HIP = O_HRP + 2 * 4 * 32 * 64, O_MKP = O_HIP + 2 * 4 * 32 * 64,
                 O_MVP = O_MKP + (size_t)2 * 4 * 256 * 512, O_KS = O_MVP + (size_t)2 * 4 * 256 * 512, O_VS = O_KS + (size_t)2 * 128 * 128 * 128,
                 O_HRS = O_VS + (size_t)2 * 128 * 128 * 128, O_HIS = O_HRS + (size_t)2 * 128 * 32 * 64, O_END = O_HIS + (size_t)2 * 128 * 32 * 64;

constexpr size_t MiB = 1u << 20;
constexpr size_t WS_ROPE = 1 * MiB, WS_LAM = 3 * MiB, WS_BP = 3 * MiB + 128 * 1024, WS_SST = 4 * MiB, WS_MEMN = 8 * MiB, WS_KVMEM = 10 * MiB,
                 WS_MK = 14 * MiB, WS_MV = 15 * MiB, WS_W = 16 * MiB, W_LAYER = 36 * MiB,
                 OFF_WIN = 0, OFF_WMKV = 10 * MiB, OFF_WGLU = 12 * MiB, OFF_WBR = 13 * MiB, OFF_WOUT = 16 * MiB, OFF_WUP = 18 * MiB, OFF_WDN = 29 * MiB + 512 * 1024,
                 WS_XN = 88 * MiB, WS_MERGED = 121 * MiB, WS_BR = 154 * MiB, WS_ZS = 204 * MiB, WS_Z = 221 * MiB, WS_H = WS_Z,
                 WS_LAMP = 378 * MiB, WS_BT1 = 380 * MiB, WS_BT2 = 396 * MiB, WS_A2 = 436 * MiB, WS_SS = 456 * MiB, WS_PART = 464 * MiB, WS_END = 486 * MiB;
static_assert(OFF_WDN + (size_t)1024 * 2816 * 2 <= W_LAYER, "weights");
static_assert(WS_Z + (size_t)MT * INW * 2 <= WS_LAMP, "Z");

constexpr int LDS_BYTES = 147456;
constexpr int NPS = 11;
constexpr int NPHASE = 1 + NPS * DEPTH;

struct Params { const float* in[32]; float* out; unsigned char* ws; int ph_lo, ph_hi; };

__device__ const double INVF[32] = {1.0,0.7498942093324559,0.5623413251903491,0.4216965034285822,0.31622776601683794,0.23713737056616552,0.1778279410038923,0.1333521432163324,0.1,0.07498942093324558,0.05623413251903491,0.042169650342858224,0.03162277660168379,0.023713737056616554,0.01778279410038923,0.01333521432163324,0.01,0.007498942093324558,0.005623413251903491,0.004216965034285823,0.0031622776601683794,0.0023713737056616554,0.0017782794100389228,0.001333521432163324,0.001,0.0007498942093324559,0.0005623413251903491,0.00042169650342858224,0.00031622776601683794,0.00023713737056616554,0.00017782794100389227,0.0001333521432163324};

__device__ __forceinline__ float bf2f(unsigned h) { return __uint_as_float(h << 16); }
__device__ __forceinline__ unsigned f2bf(float f) { unsigned u = __float_as_uint(f); return (u + 0x7fffu + ((u >> 16) & 1u)) >> 16; }
__device__ __forceinline__ unsigned pk2(float lo, float hi) { return f2bf(lo) | (f2bf(hi) << 16); }
typedef float f32x2_t __attribute__((ext_vector_type(2))); typedef __bf16 bf16x2_t __attribute__((ext_vector_type(2)));
__device__ __forceinline__ unsigned pk2h(float lo, float hi) { const f32x2_t v = {lo, hi}; const bf16x2_t b = __builtin_convertvector(v, bf16x2_t); return __builtin_bit_cast(unsigned, b); }
__device__ __forceinline__ float lo16(unsigned w) { return __uint_as_float(w << 16); }
__device__ __forceinline__ float hi16(unsigned w) { return __uint_as_float(w & 0xffff0000u); }
__device__ __forceinline__ float sigm(float x) { return __builtin_amdgcn_rcpf(1.0f + __builtin_amdgcn_exp2f(-1.4426950408889634f * x)); }
__device__ __forceinline__ float gelu_tanh(float y) { const float a = 0.7978845608028654f * (y + 0.044715f * y * y * y); const float th = 1.0f - 2.0f * __builtin_amdgcn_rcpf(__expf(2.0f * a) + 1.0f); return 0.5f * y * (1.0f + th); }
__device__ __forceinline__ float wave_sum(float v) {
#pragma unroll
    for (int o = 1; o < 64; o <<= 1) v += __shfl_xor(v, o);
    return v;
}
__device__ __forceinline__ void sincos_d(double x, double& s, double& c) {
    const double kd = rint(x * 0.63661977236758134308);
    double r = fma(-kd, 1.57079632679489655800e+00, x); r = fma(-kd, 6.12323399573676603587e-17, r);
    const int q = ((int)kd) & 3;
    const double r2 = r * r;
    const double sp = r * (1.0 + r2 * (-1.0 / 6.0 + r2 * (1.0 / 120.0 + r2 * (-1.0 / 5040.0 + r2 * (1.0 / 362880.0 + r2 * (-1.0 / 39916800.0 + r2 * (1.0 / 6227020800.0 + r2 * (-1.0 / 1307674368000.0 + r2 * (1.0 / 355687428096000.0)))))))));
    const double cp = 1.0 + r2 * (-0.5 + r2 * (1.0 / 24.0 + r2 * (-1.0 / 720.0 + r2 * (1.0 / 40320.0 + r2 * (-1.0 / 3628800.0 + r2 * (1.0 / 479001600.0 + r2 * (-1.0 / 87178291200.0 + r2 * (1.0 / 20922789888000.0))))))));
    s = (q == 0) ? sp : (q == 1) ? cp : (q == 2) ? -sp : -cp;
    c = (q == 0) ? cp : (q == 1) ? -sp : (q == 2) ? -cp : sp;
}

namespace pg8 {
#define PG8_LAS __attribute__((address_space(3)))
constexpr int BM = 256, BK = 64, HALF = 128, HTB = HALF * BK * 2, STAGE_BYTES = 8 * HTB, NXCD = 8, WGM = 4;
__host__ __device__ __forceinline__ int lds_byte(int r, int c) { const int st = (r >> 4) * 2 + (c >> 5), rr = r & 15, cc = c & 31, ob = rr * 64 + cc * 2; return st * 1024 + (ob ^ (((ob >> 9) & 1) << 5)); }
__host__ __device__ __forceinline__ void stage_rc(int b, int& R, int& C) { const int st = b / 1024, sb = b % 1024, swz = sb ^ (((sb >> 9) & 1) << 5); R = (st >> 1) * 16 + swz / 64; C = (st & 1) * 32 + (swz % 64) / 2; }
__host__ __device__ __forceinline__ int perm32(int rho) { const int n = rho >> 4, i = rho & 15; return 8 * (i >> 2) + 4 * n + (i & 3); }
struct Unit { int pm, pn, ko; };
struct Gemm { const bf16* A; const bf16* Bt; int M, N, K, lda, ldb; };
struct StaticOrder {
    int nM, nN, nwg, G, c;
    __host__ __device__ void init(int M, int N, int G_, int c_) { nM = M / BM; nN = N / BM; nwg = nM * nN; G = G_; c = c_; }
    __host__ __device__ bool next(int i, Unit& u) const {
        const long L = (long)i * G + c; if (L >= nwg) return false;
        int wgid = (int)L; { const int q = nwg / NXCD, r = nwg % NXCD, xcd = wgid % NXCD, off = wgid / NXCD; wgid = (xcd < r ? xcd * (q + 1) : r * (q + 1) + (xcd - r) * q) + off; }
        const int nig = WGM * nN, gid = wgid / nig, fm = gid * WGM, gsz = (nM - fm) < WGM ? (nM - fm) : WGM;
        u.pm = fm + ((wgid % nig) % gsz); u.pn = (wgid % nig) / gsz; u.ko = 0; return true;
    }
    __device__ __forceinline__ void a_ready(const Unit&) const {}
    __device__ __forceinline__ void done(const Unit&) const {}
};
struct GroupOrder {
    int G, c, nunits, mode;
    __device__ bool next(int i, Unit& u) const { int L = i * G + c; if (L >= nunits) return false;
        if (G == 256 && i == 0) { const int x = c & 7, y = c >> 3;
            L = (mode == 0) ? 2 * (x + 8 * (y >> 1)) + (y & 1) : 4 * (x + 8 * (y >> 2)) + (y & 3); }
        u.ko = 0; if (mode == 0) { u.pm = L; u.pn = L >> 1; } else { const int g = L >> 2; u.pm = 2 * g + ((L >> 1) & 1); u.pn = 2 * g + (L & 1); } return true; }
    __device__ __forceinline__ void a_ready(const Unit&) const {}
    __device__ __forceinline__ void done(const Unit&) const {}
};
struct RangeOrder {
    int G, c, pm0, nm, nn;
    __device__ bool next(int i, Unit& u) const { if (c < 0) return false; const int L = i * G + c; if (L >= nm * nn) return false; u.pm = pm0 + L / nn; u.pn = L % nn; u.ko = 0; return true; }
    __device__ __forceinline__ void a_ready(const Unit&) const {}
    __device__ __forceinline__ void done(const Unit&) const {}
};
struct TailOrder {
    int c, S, kslice_bytes, G;
    __device__ bool next(int i, Unit& u) const { const int L = i * G + c; if (c < 0 || L >= 8 * S) return false; const int un = L / S, ks = L - un * S; u.pm = 64 + (un >> 2); u.pn = un & 3; u.ko = ks * kslice_bytes; return true; }
    __device__ __forceinline__ void a_ready(const Unit&) const {}
    __device__ __forceinline__ void done(const Unit&) const {}
};
__device__ __forceinline__ u32x4 pack8(const f32x4 a, const f32x4 b) { u32x4 w; w.x = pk2h(a[0], a[1]); w.y = pk2h(a[2], a[3]); w.z = pk2h(b[0], b[1]); w.w = pk2h(b[2], b[3]); return w; }

struct EpiZ {
    static constexpr bool PERM = true, AFTER_DRAIN = false, HOOK = false;
    bf16* O; int ldc; int sig_from; bf16* A2;
    __device__ __forceinline__ void operator()(const f32x4 (&acc)[2][2][4][2], const Unit& u, int wr, int wc, int fr, int fq) const {
        const int row0 = u.pm * BM + wr * 64 + fr, col0 = u.pn * BM + wc * 32 + 8 * fq; const bool sg = u.pn >= sig_from;
#pragma unroll
        for (int ai = 0; ai < 2; ++ai)
#pragma unroll
            for (int m = 0; m < 4; ++m) { bf16* rowp = O + (size_t)(row0 + ai * HALF + m * 16) * ldc + col0;
#pragma unroll
                for (int bj = 0; bj < 2; ++bj) { f32x4 v0 = acc[ai][bj][m][0], v1 = acc[ai][bj][m][1];
                    if (sg) {
#pragma unroll
                        for (int e = 0; e < 4; ++e) { v0[e] = sigm(v0[e]); v1[e] = sigm(v1[e]); } }
                    const u32x4 pk = pack8(v0, v1); const bool utile = (u.pn == 3 || u.pn == 4) && u.pm < MP / BM;
                    if (!utile) *(u32x4*)(rowp + bj * HALF) = pk;
                    if (utile) { const int r = row0 + ai * HALF + m * 16, gg = (u.pn - 3) * 16 + bj * 8 + wc * 2 + (fq >> 1), t = r & (SEQ - 1);
                        *(u32x4*)(A2 + (size_t)(gg * 512 + (r >> 12) * 128 + (t >> 5)) * 640 + (t & 31) * 16 + (fq & 1) * 8) = pk; } } }
    }
};
struct EpiS {
    static constexpr bool PERM = false, AFTER_DRAIN = false, HOOK = false;
    float* SS;
    __device__ __forceinline__ void operator()(const f32x4 (&acc)[2][2][4][2], const Unit& u, int wr, int wc, int fr, int fq) const {
        const int row0 = u.pm * BM + wr * 64 + fr, col0 = wc * 32 + 4 * fq;
#pragma unroll
        for (int ai = 0; ai < 2; ++ai)
#pragma unroll
            for (int m = 0; m < 4; ++m) { float* rp = SS + (size_t)(row0 + ai * HALF + m * 16) * 128 + col0;
#pragma unroll
                for (int n = 0; n < 2; ++n) *(f32x4*)(rp + n * 16) = acc[ai][0][m][n]; }
    }
};
struct EpiY {
    static constexpr bool PERM = true, AFTER_DRAIN = false, HOOK = false;
    const bf16* A2; const float* Dv; bf16* ZS;
    __device__ __forceinline__ void operator()(const f32x4 (&acc)[2][2][4][2], const Unit& u, int wr, int wc, int fr, int fq) const {
        const int row0 = u.pm * BM + wr * 64 + fr, gg = u.pm >> 1, ct = u.pn & 1;
        const int cc0 = ct * 256 + wc * 32 + 8 * fq;
        const int c0 = cc0 & 15;
        const f32x4 d0 = *(const f32x4*)(Dv + gg * 16 + c0), d1 = *(const f32x4*)(Dv + gg * 16 + c0 + 4);
#pragma unroll
        for (int ai = 0; ai < 2; ++ai) { u32x4 uv[4][2];
#pragma unroll
            for (int m = 0; m < 4; ++m)
#pragma unroll
                for (int bj = 0; bj < 2; ++bj) uv[m][bj] = *(const u32x4*)(A2 + (size_t)(row0 + ai * HALF + m * 16) * 640 + ((cc0 + bj * HALF) >> 4) * 16 + c0);
            __builtin_amdgcn_sched_barrier(0);
#pragma unroll
            for (int m = 0; m < 4; ++m) { const int grow = row0 + ai * HALF + m * 16, bjr = grow & 511, b = bjr >> 7, j = bjr & 127;
#pragma unroll
                for (int bj = 0; bj < 2; ++bj) { const int t = (cc0 + bj * HALF) >> 4; const u32x4 uu = uv[m][bj];
                    const f32x4 a0 = acc[ai][bj][m][0], a1 = acc[ai][bj][m][1]; f32x4 v0, v1;
                    v0[0] = gelu_tanh(fmaf(d0[0], lo16(uu.x), a0[0])); v0[1] = gelu_tanh(fmaf(d0[1], hi16(uu.x), a0[1])); v0[2] = gelu_tanh(fmaf(d0[2], lo16(uu.y), a0[2])); v0[3] = gelu_tanh(fmaf(d0[3], hi16(uu.y), a0[3]));
                    v1[0] = gelu_tanh(fmaf(d1[0], lo16(uu.z), a1[0])); v1[1] = gelu_tanh(fmaf(d1[1], hi16(uu.z), a1[1])); v1[2] = gelu_tanh(fmaf(d1[2], lo16(uu.w), a1[2])); v1[3] = gelu_tanh(fmaf(d1[3], hi16(uu.w), a1[3]));
                    *(u32x4*)(ZS + (size_t)(b * SEQ + 32 * j + t) * 512 + gg * 16 + c0) = pack8(v0, v1); } }
            __builtin_amdgcn_sched_barrier(0); }
    }
};
struct EpiF32 {
    static constexpr bool PERM = false, AFTER_DRAIN = false, HOOK = false;
    float* O; int ldc;
    __device__ __forceinline__ void operator()(const f32x4 (&acc)[2][2][4][2], const Unit& u, int wr, int wc, int fr, int fq) const {
        const int row0 = u.pm * BM + wr * 64 + fr, col0 = u.pn * BM + wc * 32 + 4 * fq;
#pragma unroll
        for (int ai = 0; ai < 2; ++ai)
#pragma unroll
            for (int m = 0; m < 4; ++m) { float* rowp = O + (size_t)(row0 + ai * HALF + m * 16) * ldc + col0;
#pragma unroll
                for (int bj = 0; bj < 2; ++bj)
#pragma unroll
                    for (int n = 0; n < 2; ++n) *(f32x4*)(rowp + bj * HALF + n * 16) = acc[ai][bj][m][n]; }
    }
};
struct EpiRes {
    static constexpr bool PERM = false, AFTER_DRAIN = false, HOOK = false;
    const float* base_p; const float* base_s; float* out; int ldc;
    __device__ __forceinline__ void operator()(const f32x4 (&acc)[2][2][4][2], const Unit& u, int wr, int wc, int fr, int fq) const {
        const int row0 = u.pm * BM + wr * 64 + fr, col0 = u.pn * BM + wc * 32 + 4 * fq;
#pragma unroll
        for (int ai = 0; ai < 2; ++ai) { f32x4 bs[4][2][2];
#pragma unroll
            for (int m = 0; m < 4; ++m) { const int r = row0 + ai * HALF + m * 16; const float* bp = (r < MP) ? base_p + (size_t)r * ldc : base_s + (size_t)(r - MP) * ldc;
#pragma unroll
                for (int bj = 0; bj < 2; ++bj)
#pragma unroll
                    for (int n = 0; n < 2; ++n) bs[m][bj][n] = *(const f32x4*)(bp + col0 + bj * HALF + n * 16); }
            __builtin_amdgcn_sched_barrier(0);
#pragma unroll
            for (int m = 0; m < 4; ++m) { float* op = out + (size_t)(row0 + ai * HALF + m * 16) * ldc;
#pragma unroll
                for (int bj = 0; bj < 2; ++bj)
#pragma unroll
                    for (int n = 0; n < 2; ++n) *(f32x4*)(op + col0 + bj * HALF + n * 16) = bs[m][bj][n] + acc[ai][bj][m][n]; }
            __builtin_amdgcn_sched_barrier(0); }
    }
};
struct EpiGatePart {
    static constexpr bool PERM = false, AFTER_DRAIN = false, HOOK = false;
    const bf16* Z; float* part;
    __device__ __forceinline__ void operator()(const f32x4 (&acc)[2][2][4][2], const Unit& u, int wr, int wc, int fr, int fq) const {
        const int n = u.ko / 1024; const int row0 = u.pm * BM + wr * 64 + fr, col0 = u.pn * BM + wc * 32 + 4 * fq;
#pragma unroll
        for (int ai = 0; ai < 2; ++ai) { u32x2 gg[4][2][2];
#pragma unroll
            for (int m = 0; m < 4; ++m)
#pragma unroll
                for (int bj = 0; bj < 2; ++bj)
#pragma unroll
                    for (int nn = 0; nn < 2; ++nn) gg[m][bj][nn] = *(const u32x2*)(Z + (size_t)(row0 + ai * HALF + m * 16) * INW + GO + n * 1024 + col0 + bj * HALF + nn * 16);
            __builtin_amdgcn_sched_barrier(0);
#pragma unroll
            for (int m = 0; m < 4; ++m) { float* op = part + ((size_t)n * MS + (row0 - MP) + ai * HALF + m * 16) * DM + col0;
#pragma unroll
                for (int bj = 0; bj < 2; ++bj)
#pragma unroll
                    for (int nn = 0; nn < 2; ++nn) { const u32x2 g = gg[m][bj][nn]; const f32x4 a = acc[ai][bj][m][nn];
                        *(f32x4*)(op + bj * HALF + nn * 16) = (f32x4){a[0] * lo16(g.x), a[1] * hi16(g.x), a[2] * lo16(g.y), a[3] * hi16(g.y)}; } }
            __builtin_amdgcn_sched_barrier(0); }
    }
};
struct EpiPart {
    static constexpr bool PERM = false, AFTER_DRAIN = false, HOOK = false;
    float* part; int kslice_bytes;
    __device__ __forceinline__ void operator()(const f32x4 (&acc)[2][2][4][2], const Unit& u, int wr, int wc, int fr, int fq) const {
        const int ks = u.ko / kslice_bytes; const int row0 = (u.pm - 64) * BM + wr * 64 + fr, col0 = u.pn * BM + wc * 32 + 4 * fq;
#pragma unroll
        for (int ai = 0; ai < 2; ++ai)
#pragma unroll
            for (int m = 0; m < 4; ++m) { float* op = part + ((size_t)ks * MS + row0 + ai * HALF + m * 16) * DM + col0;
#pragma unroll
                for (int bj = 0; bj < 2; ++bj)
#pragma unroll
                    for (int n = 0; n < 2; ++n) *(f32x4*)(op + bj * HALF + n * 16) = acc[ai][bj][m][n]; }
    }
};
struct EpiGlu {
    static constexpr bool PERM = true, AFTER_DRAIN = false, HOOK = false;
    const bf16* ZS; bf16* BR;
    __device__ __forceinline__ void operator()(const f32x4 (&acc)[2][2][4][2], const Unit& u, int wr, int wc, int fr, int fq) const {
        const int row0 = u.pm * BM + wr * 64 + fr, col0 = u.pn * BM + wc * 32 + 8 * fq;
#pragma unroll
        for (int ai = 0; ai < 2; ++ai) { u32x4 zz[4][2];
#pragma unroll
            for (int m = 0; m < 4; ++m)
#pragma unroll
                for (int bj = 0; bj < 2; ++bj) zz[m][bj] = *(const u32x4*)(ZS + (size_t)(row0 + ai * HALF + m * 16) * 512 + col0 + bj * HALF);
            __builtin_amdgcn_sched_barrier(0);
#pragma unroll
            for (int m = 0; m < 4; ++m) { const int r = row0 + ai * HALF + m * 16;
#pragma unroll
                for (int bj = 0; bj < 2; ++bj) { const int c = col0 + bj * HALF; const u32x4 z = zz[m][bj];
                    const f32x4 a0 = acc[ai][bj][m][0], a1 = acc[ai][bj][m][1]; f32x4 v0, v1;
                    v0[0] = lo16(z.x) * sigm(a0[0]); v0[1] = hi16(z.x) * sigm(a0[1]); v0[2] = lo16(z.y) * sigm(a0[2]); v0[3] = hi16(z.y) * sigm(a0[3]);
                    v1[0] = lo16(z.z) * sigm(a1[0]); v1[1] = hi16(z.z) * sigm(a1[1]); v1[2] = lo16(z.w) * sigm(a1[2]); v1[3] = hi16(z.w) * sigm(a1[3]);
                    *(u32x4*)(BR + (size_t)r * 1536 + 512 + c) = pack8(v0, v1); } }
            __builtin_amdgcn_sched_barrier(0); }
    }
};
struct EpiSwiglu {
    static constexpr bool PERM = true, AFTER_DRAIN = false, HOOK = false;
    bf16* H;
    __device__ __forceinline__ void operator()(const f32x4 (&acc)[2][2][4][2], const Unit& u, int wr, int wc, int fr, int fq) const {
        const int row0 = u.pm * BM + wr * 64 + fr, col0 = u.pn * HALF + wc * 32 + 8 * fq;
#pragma unroll
        for (int ai = 0; ai < 2; ++ai)
#pragma unroll
            for (int m = 0; m < 4; ++m) { const int r = row0 + ai * HALF + m * 16; f32x4 v0, v1;
#pragma unroll
                for (int e = 0; e < 4; ++e) { const float g0 = acc[ai][0][m][0][e], g1 = acc[ai][0][m][1][e]; v0[e] = g0 * sigm(g0) * acc[ai][1][m][0][e]; v1[e] = g1 * sigm(g1) * acc[ai][1][m][1][e]; }
                *(u32x4*)(H + (size_t)r * DFF + col0) = pack8(v0, v1); }
    }
};
struct EpiMerge {
    static constexpr bool PERM = true, AFTER_DRAIN = false, HOOK = true;
    const bf16* Z; bf16* O;
    __device__ __forceinline__ void hook(f32x4 (&acc)[2][2][4][2], const Unit& u, int t, int wr, int wc, int fr, int fq) const {
        const int n = (t >> 3) - 1; int frx = fr, fqx = fq; asm volatile("" : "+v"(frx), "+v"(fqx)); const int row0 = u.pm * BM + wr * 64 + frx, col0 = u.pn * BM + wc * 32 + 8 * fqx;
#pragma unroll
        for (int ai = 0; ai < 2; ++ai) { u32x4 ga[4][2], gb[4][2];
#pragma unroll
            for (int m = 0; m < 4; ++m) { const bf16* zr = Z + (size_t)(row0 + ai * HALF + m * 16) * INW + GO + n * 1024 + col0;
#pragma unroll
                for (int bj = 0; bj < 2; ++bj) { ga[m][bj] = *(const u32x4*)(zr + bj * HALF); gb[m][bj] = *(const u32x4*)(zr + 1024 + bj * HALF); } }
            __builtin_amdgcn_sched_barrier(0);
#pragma unroll
            for (int m = 0; m < 4; ++m)
#pragma unroll
                for (int bj = 0; bj < 2; ++bj) { const unsigned aw[4] = {ga[m][bj].x, ga[m][bj].y, ga[m][bj].z, ga[m][bj].w}, bw[4] = {gb[m][bj].x, gb[m][bj].y, gb[m][bj].z, gb[m][bj].w};
#pragma unroll
                    for (int e = 0; e < 4; ++e) { const float r0 = fmaxf(lo16(aw[e]), 1e-20f) * __builtin_amdgcn_rcpf(fmaxf(lo16(bw[e]), 1e-20f)), r1 = fmaxf(hi16(aw[e]), 1e-20f) * __builtin_amdgcn_rcpf(fmaxf(hi16(bw[e]), 1e-20f));
                        acc[ai][bj][m][e >> 1][(e & 1) * 2] *= r0; acc[ai][bj][m][e >> 1][(e & 1) * 2 + 1] *= r1; } }
            __builtin_amdgcn_sched_barrier(0); }
    }
    __device__ __forceinline__ void operator()(const f32x4 (&acc)[2][2][4][2], const Unit& u, int wr, int wc, int fr, int fq) const {
        const int row0 = u.pm * BM + wr * 64 + fr, col0 = u.pn * BM + wc * 32 + 8 * fq;
#pragma unroll
        for (int ai = 0; ai < 2; ++ai) { u32x4 gg[4][2];
#pragma unroll
            for (int m = 0; m < 4; ++m)
#pragma unroll
                for (int bj = 0; bj < 2; ++bj) gg[m][bj] = *(const u32x4*)(Z + (size_t)(row0 + ai * HALF + m * 16) * INW + GO + 2048 + col0 + bj * HALF);
            __builtin_amdgcn_sched_barrier(0);
#pragma unroll
            for (int m = 0; m < 4; ++m) { const int r = row0 + ai * HALF + m * 16;
#pragma unroll
                for (int bj = 0; bj < 2; ++bj) { const unsigned gw[4] = {gg[m][bj].x, gg[m][bj].y, gg[m][bj].z, gg[m][bj].w}; f32x4 v0, v1;
#pragma unroll
                    for (int e = 0; e < 2; ++e) { v0[2 * e] = acc[ai][bj][m][0][2 * e] * fmaxf(lo16(gw[e]), 1e-20f); v0[2 * e + 1] = acc[ai][bj][m][0][2 * e + 1] * fmaxf(hi16(gw[e]), 1e-20f);
                        v1[2 * e] = acc[ai][bj][m][1][2 * e] * fmaxf(lo16(gw[2 + e]), 1e-20f); v1[2 * e + 1] = acc[ai][bj][m][1][2 * e + 1] * fmaxf(hi16(gw[2 + e]), 1e-20f); }
                    *(u32x4*)(O + (size_t)r * DM + col0 + bj * HALF) = pack8(v0, v1); } }
            __builtin_amdgcn_sched_barrier(0); }
    }
};

template <class Epi, class Sched, bool ALIGN_EPI = false, bool SP2 = false>
__device__ __forceinline__ void gemm_phase(PG8_LAS unsigned char* lds, const Gemm g, const Sched& S, const Epi& E) {
    const int tid = threadIdx.x, wid = __builtin_amdgcn_readfirstlane(tid >> 6), lane = tid & 63, wr = wid >> 2, wc = wid & 3, fr = lane & 15, fq = lane >> 4;
    const int K = g.K, nt = K / BK, lda = g.lda, ldb = g.ldb;
    unsigned voffA[2], voffB[2];
#pragma unroll
    for (int i = 0; i < 2; ++i) { int R, C; stage_rc(tid * 16 + i * 8192, R, C); const int Rb = Epi::PERM ? ((R & ~31) + perm32(R & 31)) : R;
        voffA[i] = (unsigned)(R * lda + C) * 2u; voffB[i] = (unsigned)(Rb * ldb + C) * 2u; }
    const size_t kstep = (size_t)(BK * 2);
    const size_t hstep = (size_t)HALF * ldb * 2;
    const size_t tstep = 2 * hstep;
    const size_t hstepA = (size_t)HALF * lda * 2, tstepA = 2 * hstepA;
    const unsigned ldsw = (unsigned)wid * 1024u;
    const int aoff = lds_byte(wr * 64 + fr, fq * 8), boff = lds_byte(wc * 32 + fr, fq * 8);
#define PG8_SA(b, h) (((b) * 2 + (h)) * HTB)
#define PG8_SB(b, h) ((4 + (b) * 2 + (h)) * HTB)
#define PG8_STAGE(bufoff, gbase, voff) do { _Pragma("unroll") for (int _i = 0; _i < 2; ++_i) \
        __builtin_amdgcn_global_load_lds((const unsigned*)((const char*)(gbase) + (voff)[_i]), (PG8_LAS unsigned*)(lds + (bufoff) + ldsw + _i * 8192), 16, 0, 0); } while (0)
#define PG8_LDA(dst, b, h) do { _Pragma("unroll") for (int m = 0; m < 4; ++m) _Pragma("unroll") for (int k = 0; k < 2; ++k) dst[m][k] = *(const PG8_LAS bf16x8*)(lds + PG8_SA(b, h) + aoff + m * 2048 + k * 1024); } while (0)
#define PG8_LDB(dst, b, h) do { _Pragma("unroll") for (int n = 0; n < 2; ++n) _Pragma("unroll") for (int k = 0; k < 2; ++k) dst[n][k] = *(const PG8_LAS bf16x8*)(lds + PG8_SB(b, h) + boff + n * 2048 + k * 1024); } while (0)
#define PG8_MMA(ai, bj, At, Bt) do { __builtin_amdgcn_s_setprio(1); _Pragma("unroll") for (int m = 0; m < 4; ++m) _Pragma("unroll") for (int n = 0; n < 2; ++n) _Pragma("unroll") for (int k = 0; k < 2; ++k) \
        acc[ai][bj][m][n] = __builtin_amdgcn_mfma_f32_16x16x32_bf16(Bt[n][k], At[m][k], acc[ai][bj][m][n], 0, 0, 0); __builtin_amdgcn_s_setprio(0); } while (0)
#define PG8_WAIT_V(n) asm volatile("s_waitcnt vmcnt(" #n ")" ::: "memory")
#define PG8_WAIT_L(n) asm volatile("s_waitcnt lgkmcnt(" #n ")" ::: "memory")
#define PG8_BAR __builtin_amdgcn_s_barrier()
#define PG8_SCHED __builtin_amdgcn_sched_barrier(0)
    Unit cur, nxt; int ui = 0;
    if (!S.next(0, cur)) return;
    f32x4 acc[2][2][4][2];
#pragma unroll
    for (int a = 0; a < 2; ++a)
#pragma unroll
        for (int b = 0; b < 2; ++b)
#pragma unroll
            for (int m = 0; m < 4; ++m)
#pragma unroll
                for (int n = 0; n < 2; ++n) acc[a][b][m][n] = (f32x4){0.f, 0.f, 0.f, 0.f};
    bf16x8 At[4][2], B0[2][2], B1[2][2];
    const char* cA = (const char*)g.A + (size_t)cur.pm * tstepA + cur.ko; const char* cB = (const char*)g.Bt + (size_t)cur.pn * tstep + cur.ko;
    S.a_ready(cur);
    if constexpr (SP2) {
        PG8_STAGE(PG8_SB(0, 0), cB, voffB); PG8_STAGE(PG8_SB(0, 1), cB + hstep, voffB); PG8_STAGE(PG8_SA(0, 0), cA, voffA); PG8_STAGE(PG8_SA(0, 1), cA + hstepA, voffA);
        if (wr == 1) PG8_BAR;
        PG8_WAIT_V(2); PG8_BAR;
        PG8_STAGE(PG8_SB(1, 0), cB + kstep, voffB); PG8_STAGE(PG8_SA(1, 0), cA + kstep, voffA); PG8_STAGE(PG8_SB(1, 1), cB + hstep + kstep, voffB);
        PG8_WAIT_V(6); PG8_BAR;
    } else {
        PG8_STAGE(PG8_SB(0, 0), cB, voffB); PG8_STAGE(PG8_SA(0, 0), cA, voffA); PG8_STAGE(PG8_SB(0, 1), cB + hstep, voffB); PG8_STAGE(PG8_SA(0, 1), cA + hstepA, voffA);
        if (wr == 1) PG8_BAR;
        PG8_WAIT_V(4); PG8_BAR;
        PG8_STAGE(PG8_SB(1, 0), cB + kstep, voffB); PG8_STAGE(PG8_SA(1, 0), cA + kstep, voffA); PG8_STAGE(PG8_SB(1, 1), cB + hstep + kstep, voffB);
        PG8_WAIT_V(6); PG8_BAR;
    }
    for (;;) {
        const bool has_next = S.next(ui + 1, nxt);
        const char* nA = has_next ? (const char*)g.A + (size_t)nxt.pm * tstepA + nxt.ko : cA; const char* nB = has_next ? (const char*)g.Bt + (size_t)nxt.pn * tstep + nxt.ko : cB;
        for (int t = 0; t < nt; t += 2) {
            const bool last = (t == nt - 2);
            const char* a1 = cA + (size_t)(t + 1) * kstep;
            const char* a2 = last ? nA : cA + (size_t)(t + 2) * kstep; const char* b2 = last ? nB : cB + (size_t)(t + 2) * kstep;
            const char* a3 = a2 + kstep; const char* b3 = b2 + kstep;
            if (last && has_next) S.a_ready(nxt);
            if constexpr (Epi::HOOK) { if (t == 8 || t == 16) E.hook(acc, cur, t, wr, wc, fr, fq); }
            if constexpr (SP2) {
            PG8_LDB(B0, 0, 0); PG8_LDB(B1, 0, 1); PG8_SCHED; PG8_LDA(At, 0, 0); PG8_STAGE(PG8_SA(1, 1), a1 + hstepA, voffA);
            PG8_WAIT_V(8); PG8_WAIT_L(0); PG8_BAR; PG8_MMA(0, 0, At, B0); PG8_MMA(0, 1, At, B1); PG8_BAR; PG8_SCHED;
            PG8_LDA(At, 0, 1); PG8_STAGE(PG8_SB(0, 0), b2, voffB); PG8_STAGE(PG8_SB(0, 1), b2 + hstep, voffB); PG8_STAGE(PG8_SA(0, 0), a2, voffA);
            PG8_WAIT_V(8); PG8_WAIT_L(0); PG8_BAR; PG8_MMA(1, 0, At, B0); PG8_MMA(1, 1, At, B1); PG8_BAR; PG8_SCHED;
            PG8_LDB(B0, 1, 0); PG8_LDB(B1, 1, 1); PG8_SCHED; PG8_LDA(At, 1, 0); PG8_STAGE(PG8_SA(0, 1), a2 + hstepA, voffA);
            PG8_WAIT_V(8); PG8_WAIT_L(0); PG8_BAR; PG8_MMA(0, 0, At, B0); PG8_MMA(0, 1, At, B1); PG8_BAR; PG8_SCHED;
            PG8_LDA(At, 1, 1); PG8_STAGE(PG8_SB(1, 0), b3, voffB); PG8_STAGE(PG8_SB(1, 1), b3 + hstep, voffB); PG8_STAGE(PG8_SA(1, 0), a3, voffA);
            PG8_WAIT_V(8); PG8_WAIT_L(0); PG8_BAR; PG8_MMA(1, 0, At, B0); PG8_MMA(1, 1, At, B1); PG8_BAR; PG8_SCHED;
            } else {
            PG8_LDB(B0, 0, 0); PG8_SCHED; PG8_LDA(At, 0, 0); PG8_STAGE(PG8_SA(1, 1), a1 + hstepA, voffA);
            PG8_WAIT_L(8); PG8_BAR; PG8_WAIT_L(0); PG8_MMA(0, 0, At, B0); PG8_BAR; PG8_SCHED;
            PG8_LDB(B1, 0, 1); PG8_STAGE(PG8_SB(0, 0), b2, voffB);
            PG8_BAR; PG8_WAIT_L(0); PG8_MMA(0, 1, At, B1); PG8_BAR;
            PG8_LDA(At, 0, 1); PG8_STAGE(PG8_SA(0, 0), a2, voffA);
            PG8_BAR; PG8_WAIT_L(0); PG8_MMA(1, 0, At, B0); PG8_BAR; PG8_SCHED;
            PG8_STAGE(PG8_SB(0, 1), b2 + hstep, voffB);
            PG8_WAIT_V(6); PG8_BAR; PG8_MMA(1, 1, At, B1); PG8_BAR;
            PG8_LDB(B0, 1, 0); PG8_SCHED; PG8_LDA(At, 1, 0); PG8_STAGE(PG8_SA(0, 1), a2 + hstepA, voffA);
            PG8_WAIT_L(8); PG8_BAR; PG8_WAIT_L(0); PG8_MMA(0, 0, At, B0); PG8_BAR; PG8_SCHED;
            PG8_LDB(B1, 1, 1); PG8_STAGE(PG8_SB(1, 0), b3, voffB);
            PG8_BAR; PG8_WAIT_L(0); PG8_MMA(0, 1, At, B1); PG8_BAR;
            PG8_LDA(At, 1, 1); PG8_STAGE(PG8_SA(1, 0), a3, voffA);
            PG8_BAR; PG8_WAIT_L(0); PG8_MMA(1, 0, At, B0); PG8_BAR; PG8_SCHED;
            PG8_STAGE(PG8_SB(1, 1), b3 + hstep, voffB);
            PG8_WAIT_V(6); PG8_BAR; PG8_MMA(1, 1, At, B1); PG8_BAR;
            }
        }
        if constexpr (ALIGN_EPI) { if (wr == 0) PG8_BAR; }
        if constexpr (!Epi::AFTER_DRAIN) { E(acc, cur, wr, wc, fr, fq); S.done(cur); }
        if (!has_next) break;
#pragma unroll
        for (int a = 0; a < 2; ++a)
#pragma unroll
            for (int b = 0; b < 2; ++b)
#pragma unroll
                for (int m = 0; m < 4; ++m)
#pragma unroll
                    for (int n = 0; n < 2; ++n) acc[a][b][m][n] = (f32x4){0.f, 0.f, 0.f, 0.f};
        cur = nxt; cA = nA; cB = nB; ++ui;
        if constexpr (ALIGN_EPI) { if (wr == 1) PG8_BAR; }
    }
    PG8_WAIT_V(0);
    if constexpr (!ALIGN_EPI) { if (wr == 0) PG8_BAR; }
    PG8_BAR;
#undef PG8_SA
#undef PG8_SB
#undef PG8_STAGE
#undef PG8_LDA
#undef PG8_LDB
#undef PG8_MMA
#undef PG8_WAIT_V
#undef PG8_WAIT_L
#undef PG8_BAR
#undef PG8_SCHED
}
}

__device__ __forceinline__ void transpose_item(const float* W, int N, bf16* WT, int ldt, int koff, const float* gain, int upperm, LAS float* scr, int kb, int nb, int lane) {
    const int k0 = 64 * kb, n0 = 64 * nb;
    f32x4 v[16]; float gv[16];
#pragma unroll
    for (int i = 0; i < 16; ++i) { const int kk = 4 * i + (lane >> 4); v[i] = *(const f32x4*)(W + (size_t)(k0 + kk) * N + n0 + (lane & 15) * 4); gv[i] = gain ? gain[k0 + kk] : 1.0f; }
    __builtin_amdgcn_sched_barrier(0);
#pragma unroll
    for (int i = 0; i < 16; ++i) { const int kk = 4 * i + (lane >> 4); const float gg = gv[i]; LAS float* s = scr + kk * 65 + (lane & 15) * 4;
        s[0] = v[i].x * gg; s[1] = v[i].y * gg; s[2] = v[i].z * gg; s[3] = v[i].w * gg; }
    asm volatile("s_waitcnt lgkmcnt(0)" ::: "memory");
    const int c = lane & 7;
#pragma unroll
    for (int j = 0; j < 8; ++j) { const int n = (lane >> 3) + 8 * j; const LAS float* s = scr + (8 * c) * 65 + n;
        u32x4 o; o.x = pk2h(s[0 * 65], s[1 * 65]); o.y = pk2h(s[2 * 65], s[3 * 65]); o.z = pk2h(s[4 * 65], s[5 * 65]); o.w = pk2h(s[6 * 65], s[7 * 65]);
        int dr = n0 + n; if (upperm) { dr = (dr < DFF) ? (dr >> 7) * 256 + (dr & 127) : ((dr - DFF) >> 7) * 256 + 128 + ((dr - DFF) & 127); }
        *(u32x4*)(WT + (size_t)dr * ldt + koff + k0 + 8 * c) = o; }
    asm volatile("s_waitcnt lgkmcnt(0)" ::: "memory");
}
constexpr int TI_WIN = 16 * 76, TI_MKV = 16 * 16, TI_GLU = 8 * 8, TI_BR = 8 * 16, TI_OUT = 16 * 16, TI_UP = 16 * 88, TI_DN = 44 * 16;
constexpr int TI_LAYER = TI_WIN + TI_MKV + TI_GLU + 3 * TI_BR + TI_OUT + TI_UP + TI_DN;
__device__ __forceinline__ void weight_item(const Params& P, int it, LAS float* scr, int lane) {
    const int l = it / TI_LAYER; int r = it % TI_LAYER;
    unsigned char* wb = P.ws + WS_W + (size_t)l * W_LAYER;
    const float* W; int N; bf16* WT; int ldt, koff = 0, up = 0; const float* gain = nullptr;
    if (r < TI_WIN) { W = P.in[10] + (size_t)l * DM * INW; N = INW; WT = (bf16*)(wb + OFF_WIN); ldt = DM; gain = P.in[9] + l * DM; }
    else if ((r -= TI_WIN) < TI_MKV) { W = P.in[24] + (size_t)l * DM * 1024; N = 1024; WT = (bf16*)(wb + OFF_WMKV); ldt = DM; gain = P.in[23] + l * DM; }
    else if ((r -= TI_MKV) < TI_GLU) { W = P.in[22] + (size_t)l * 512 * 512; N = 512; WT = (bf16*)(wb + OFF_WGLU); ldt = 512; }
    else if ((r -= TI_GLU) < 3 * TI_BR) { const int nbr = r / TI_BR; r -= nbr * TI_BR; W = P.in[27] + ((size_t)l * 3 + nbr) * 512 * DM; N = DM; WT = (bf16*)(wb + OFF_WBR); ldt = 1536; koff = nbr * 512; }
    else if ((r -= 3 * TI_BR) < TI_OUT) { W = P.in[28] + (size_t)l * DM * DM; N = DM; WT = (bf16*)(wb + OFF_WOUT); ldt = DM; }
    else if ((r -= TI_OUT) < TI_UP) { W = P.in[30] + (size_t)l * DM * 2 * DFF; N = 2 * DFF; WT = (bf16*)(wb + OFF_WUP); ldt = DM; gain = P.in[29] + l * DM; up = 1; }
    else { r -= TI_UP; W = P.in[31] + (size_t)l * DFF * DM; N = DM; WT = (bf16*)(wb + OFF_WDN); ldt = DFF; }
    const int nblk = N / 64;
    transpose_item(W, N, WT, ldt, koff, gain, up, scr, r / nblk, r % nblk, lane);
}
__device__ __forceinline__ void rms_row_to_bf16(const float* xrow, bf16* orow, int lane, const float* part = nullptr, int npart = 0, float* xout = nullptr, bool want_xn = true) {
    const f32x4* xr = (const f32x4*)xrow + lane;
    f32x4 v[4]; float s = 0.f;
#pragma unroll
    for (int j = 0; j < 4; ++j) v[j] = xr[64 * j];
    if (part) { for (int k = 0; k < npart; ++k) { const f32x4* pr = (const f32x4*)(part + (size_t)k * MS * DM) + lane;
#pragma unroll
            for (int j = 0; j < 4; ++j) v[j] += pr[64 * j]; }
#pragma unroll
        for (int j = 0; j < 4; ++j) ((f32x4*)xout + lane)[64 * j] = v[j]; }
    if (!want_xn) return;
#pragma unroll
    for (int j = 0; j < 4; ++j) s += (v[j].x * v[j].x + v[j].y * v[j].y) + (v[j].z * v[j].z + v[j].w * v[j].w);
    const float rstd = 1.0f / sqrtf(wave_sum(s) * (1.f / DM) + EPS);
    u32x2* o8 = (u32x2*)orow + lane;
#pragma unroll
    for (int j = 0; j < 4; ++j) { u32x2 w; w.x = pk2(v[j].x * rstd, v[j].y * rstd); w.y = pk2(v[j].z * rstd, v[j].w * rstd); o8[64 * j] = w; }
}

template <bool OUT, int NPRE = 0>
__device__ __forceinline__ void ssm_run(const bf16* Zu, int L, float lr, float li, const float (&br)[16], const float (&bi)[16], float& hr, float& hi,
                                        const float (&cr)[16], const float (&ci)[16], float dcl, bf16* zs_out, int lane) {
    const int cl = lane >> 2;
    u32x4 pu0[NPRE > 0 ? NPRE : 1], pu1[NPRE > 0 ? NPRE : 1]; unsigned short pcl[NPRE > 0 ? NPRE : 1];
    if constexpr (NPRE > 0) {
#pragma unroll
        for (int t = 0; t < NPRE; ++t) { const bf16* up = Zu + (size_t)t * INW; pu0[t] = *(const u32x4*)up; pu1[t] = *(const u32x4*)(up + 8); pcl[t] = up[cl]; }
        __builtin_amdgcn_sched_barrier(0);
    }
#pragma unroll
    for (int t = 0; t < (NPRE > 0 ? NPRE : L); ++t) {
        const bf16* up = Zu + (size_t)t * INW;
        u32x4 u0, u1; if constexpr (NPRE > 0) { u0 = pu0[t]; u1 = pu1[t]; } else { u0 = *(const u32x4*)up; u1 = *(const u32x4*)(up + 8); }
        float u[16];
        u[0] = lo16(u0.x); u[1] = hi16(u0.x); u[2] = lo16(u0.y); u[3] = hi16(u0.y); u[4] = lo16(u0.z); u[5] = hi16(u0.z); u[6] = lo16(u0.w); u[7] = hi16(u0.w);
        u[8] = lo16(u1.x); u[9] = hi16(u1.x); u[10] = lo16(u1.y); u[11] = hi16(u1.y); u[12] = lo16(u1.z); u[13] = hi16(u1.z); u[14] = lo16(u1.w); u[15] = hi16(u1.w);
        float bur = 0.f, bui = 0.f;
#pragma unroll
        for (int c = 0; c < 16; ++c) { bur = fmaf(br[c], u[c], bur); bui = fmaf(bi[c], u[c], bui); }
        const float nr = fmaf(lr, hr, fmaf(-li, hi, bur)), ni = fmaf(lr, hi, fmaf(li, hr, bui));
        hr = nr; hi = ni;
        if constexpr (OUT) {
            float v[16];
#pragma unroll
            for (int c = 0; c < 16; ++c) v[c] = fmaf(cr[c], nr, -ci[c] * ni);
            float w8[8], w4[4], w2[2];
            { const bool h = lane & 32;
#pragma unroll
              for (int i = 0; i < 8; ++i) { const float send = h ? v[i] : v[i + 8], keep = h ? v[i + 8] : v[i]; w8[i] = keep + __shfl_xor(send, 32); } }
            { const bool h = lane & 16;
#pragma unroll
              for (int i = 0; i < 4; ++i) { const float send = h ? w8[i] : w8[i + 4], keep = h ? w8[i + 4] : w8[i]; w4[i] = keep + __shfl_xor(send, 16); } }
            { const bool h = lane & 8;
#pragma unroll
              for (int i = 0; i < 2; ++i) { const float send = h ? w4[i] : w4[i + 2], keep = h ? w4[i + 2] : w4[i]; w2[i] = keep + __shfl_xor(send, 8); } }
            float y;
            { const bool h = lane & 4; const float send = h ? w2[0] : w2[1], keep = h ? w2[1] : w2[0]; y = keep + __shfl_xor(send, 4); }
            y += __shfl_xor(y, 1); y += __shfl_xor(y, 2);
            const float ucl = bf2f(NPRE > 0 ? pcl[t] : up[cl]);
            y = fmaf(dcl, ucl, y);
            const float a = 0.7978845608028654f * (y + 0.044715f * y * y * y);
            const float th = 1.0f - 2.0f * __builtin_amdgcn_rcpf(__expf(2.0f * a) + 1.0f);
            const float z = 0.5f * y * (1.0f + th);
            if ((lane & 3) == 0) zs_out[(size_t)t * 512] = (bf16)f2bf(z);
        }
    }
}

__device__ __forceinline__ bf16x8 ld_q8(const bf16* p) { return *(const bf16x8*)p; }
template <int MODE>
__device__ __forceinline__ void swa_qtile(const LAS bf16* Ksm, const LAS bf16* Vt, int kt0, const bf16* qptr, float sink, int iq, int jmin, bf16* optr, int lane) {
    constexpr int NKT = 10, KST = 72, VST = 264;
    const int lq = lane & 15, lg = lane >> 4;
    bf16x8 qf[2];
#pragma unroll
    for (int kk = 0; kk < 2; ++kk) qf[kk] = ld_q8(qptr + 32 * kk + 8 * lg);
    f32x4 s[NKT];
#pragma unroll
    for (int kt = 0; kt < NKT; ++kt) { s[kt] = (f32x4){0.f, 0.f, 0.f, 0.f};
#pragma unroll
        for (int kk = 0; kk < 2; ++kk) { const bf16x8 kf = *(const LAS bf16x8*)(Ksm + (16 * (kt0 + kt) + lq) * KST + 32 * kk + 8 * lg); s[kt] = __builtin_amdgcn_mfma_f32_16x16x32_bf16(kf, qf[kk], s[kt], 0, 0, 0); } }
    float mx = -INFINITY;
#pragma unroll
    for (int kt = 0; kt < NKT; ++kt)
#pragma unroll
        for (int e = 0; e < 4; ++e) { const int j = 16 * (kt0 + kt) + 4 * lg + e; bool ok;
            if (MODE == 0) ok = (j > iq) && (j <= iq + 128) && (j >= jmin);
            else { const int t = lq >> 2; ok = (j < 128) ? (j >= t + 1) : (j < 132 && (j - 128) <= t); }
            const float v = ok ? s[kt][e] * 0.125f : -INFINITY; s[kt][e] = v; mx = fmaxf(mx, v); }
    mx = fmaxf(mx, __shfl_xor(mx, 16)); mx = fmaxf(mx, __shfl_xor(mx, 32)); mx = fmaxf(mx, sink);
    float sum = 0.f;
#pragma unroll
    for (int kt = 0; kt < NKT; ++kt)
#pragma unroll
        for (int e = 0; e < 4; ++e) { const float p = __expf(s[kt][e] - mx); s[kt][e] = p; sum += p; }
    sum += __shfl_xor(sum, 16); sum += __shfl_xor(sum, 32);
    const float inv = 1.0f / (sum + __expf(sink - mx));
    f32x4 o[4];
#pragma unroll
    for (int dt = 0; dt < 4; ++dt) o[dt] = (f32x4){0.f, 0.f, 0.f, 0.f};
#pragma unroll
    for (int st = 0; st < NKT / 2; ++st) {
        u32x4 pw; pw.x = pk2(s[2 * st][0] * inv, s[2 * st][1] * inv); pw.y = pk2(s[2 * st][2] * inv, s[2 * st][3] * inv); pw.z = pk2(s[2 * st + 1][0] * inv, s[2 * st + 1][1] * inv); pw.w = pk2(s[2 * st + 1][2] * inv, s[2 * st + 1][3] * inv);
        const bf16x8 pf = __builtin_bit_cast(bf16x8, pw);
#pragma unroll
        for (int dt = 0; dt < 4; ++dt) { const LAS bf16* vp = Vt + (16 * dt + lq) * VST + 16 * (kt0 + 2 * st) + 4 * lg;
            const s16x4 lo = *(const LAS s16x4*)vp, hi = *(const LAS s16x4*)(vp + 16);
            const bf16x8 vf = __builtin_shufflevector(lo, hi, 0, 1, 2, 3, 4, 5, 6, 7);
            o[dt] = __builtin_amdgcn_mfma_f32_16x16x32_bf16(vf, pf, o[dt], 0, 0, 0); } }
#pragma unroll
    for (int dt = 0; dt < 4; ++dt) { u32x2 w; w.x = pk2(o[dt][0], o[dt][1]); w.y = pk2(o[dt][2], o[dt][3]); *(u32x2*)(optr + 16 * dt + 4 * lg) = w; }
}
__device__ __forceinline__ void mem_qtile(const LAS bf16* Ksm, const LAS bf16* Vt, const bf16* qptr, bf16* optr, bool store_ok, int lane) {
    constexpr int KST = 136, VST = 264;
    const int lq = lane & 15, lg = lane >> 4;
    bf16x8 qf[4];
#pragma unroll
    for (int kk = 0; kk < 4; ++kk) qf[kk] = ld_q8(qptr + 32 * kk + 8 * lg);
    f32x4 s[16];
#pragma unroll
    for (int kt = 0; kt < 16; ++kt) { s[kt] = (f32x4){0.f, 0.f, 0.f, 0.f};
#pragma unroll
        for (int kk = 0; kk < 4; ++kk) { const bf16x8 kf = *(const LAS bf16x8*)(Ksm + (16 * kt + lq) * KST + 32 * kk + 8 * lg); s[kt] = __builtin_amdgcn_mfma_f32_16x16x32_bf16(kf, qf[kk], s[kt], 0, 0, 0); } }
    float mx = -INFINITY;
#pragma unroll
    for (int kt = 0; kt < 16; ++kt)
#pragma unroll
        for (int e = 0; e < 4; ++e) { const float v = s[kt][e] * 0.08838834764831845f; s[kt][e] = v; mx = fmaxf(mx, v); }
    mx = fmaxf(mx, __shfl_xor(mx, 16)); mx = fmaxf(mx, __shfl_xor(mx, 32));
    float sum = 0.f;
#pragma unroll
    for (int kt = 0; kt < 16; ++kt)
#pragma unroll
        for (int e = 0; e < 4; ++e) { const float p = __expf(s[kt][e] - mx); s[kt][e] = p; sum += p; }
    sum += __shfl_xor(sum, 16); sum += __shfl_xor(sum, 32);
    const float inv = 1.0f / sum;
    int xs[4], ys[4]; { const int x0 = (4 * lg) ^ ((lq >> 3) << 2);
#pragma unroll
        for (int c = 0; c < 4; ++c) { xs[c] = x0 ^ (8 * c); ys[c] = xs[c] ^ 16; } }
    f32x4 o[8];
#pragma unroll
    for (int dt = 0; dt < 8; ++dt) o[dt] = (f32x4){0.f, 0.f, 0.f, 0.f};
#pragma unroll
    for (int st = 0; st < 8; ++st) {
        u32x4 pw; pw.x = pk2(s[2 * st][0] * inv, s[2 * st][1] * inv); pw.y = pk2(s[2 * st][2] * inv, s[2 * st][3] * inv); pw.z = pk2(s[2 * st + 1][0] * inv, s[2 * st + 1][1] * inv); pw.w = pk2(s[2 * st + 1][2] * inv, s[2 * st + 1][3] * inv);
        const bf16x8 pf = __builtin_bit_cast(bf16x8, pw);
#pragma unroll
        for (int dt = 0; dt < 8; ++dt) { constexpr int dummy = 0; const int cdt = (8 * dt) & 63, hi5 = (32 * st) ^ (cdt & 32), cs = (cdt >> 3) & 3; const LAS bf16* vr = Vt + (16 * dt + lq) * VST + hi5;
            const s16x4 lo = *(const LAS s16x4*)(vr + xs[cs]), hi = *(const LAS s16x4*)(vr + ys[cs]);
            const bf16x8 vf = __builtin_shufflevector(lo, hi, 0, 1, 2, 3, 4, 5, 6, 7);
            o[dt] = __builtin_amdgcn_mfma_f32_16x16x32_bf16(vf, pf, o[dt], 0, 0, 0); } }
    if (store_ok) {
#pragma unroll
        for (int dt = 0; dt < 8; ++dt) { u32x2 w; w.x = pk2(o[dt][0], o[dt][1]); w.y = pk2(o[dt][2], o[dt][3]); *(u32x2*)(optr + 16 * dt + 4 * lg) = w; }
    }
}
template <bool SWZ>
__device__ __forceinline__ void vt_scatter(LAS bf16* Vt, int vst, int d0, int key, const u32x4 v) {
    const unsigned w[4] = {v.x, v.y, v.z, v.w};
    const int kc = SWZ ? (key ^ (((d0 >> 3) & 15) << 2)) : key;
#pragma unroll
    for (int e = 0; e < 4; ++e) { Vt[(d0 + 2 * e) * vst + kc] = (bf16)(w[e] & 0xffffu); Vt[(d0 + 2 * e + 1) * vst + kc] = (bf16)(w[e] >> 16); }
}
__device__ __forceinline__ u32x4 cvt8(const float* p) { const f32x4 a = *(const f32x4*)p, b = *(const f32x4*)(p + 4); u32x4 w; w.x = pk2(a.x, a.y); w.y = pk2(a.z, a.w); w.z = pk2(b.x, b.y); w.w = pk2(b.z, b.w); return w; }

__device__ __forceinline__ void mem_prompt_item(int i2, const bf16* Z, const bf16* MK, const bf16* MV, bf16* BR, LAS unsigned char* lds, int tid, int wave, int lane) {
    const int qc = i2 & 15, hm = (i2 >> 4) & 3, b = i2 >> 6;
    LAS bf16* Ksm = (LAS bf16*)lds; LAS bf16* Vt = (LAS bf16*)(lds + 256 * 136 * 2);
    { u32x4 kq[8], vq[8];
#pragma unroll
    for (int i = 0; i < 8; ++i) { const int cid = tid + 512 * i, key = cid >> 4, ch = cid & 15; const size_t so = (size_t)(b * NMEM + key) * 512 + hm * 128 + ch * 8; kq[i] = *(const u32x4*)(MK + so); vq[i] = *(const u32x4*)(MV + so); }
    __builtin_amdgcn_sched_barrier(0);
#pragma unroll
    for (int i = 0; i < 8; ++i) { const int cid = tid + 512 * i, key = cid >> 4, ch = cid & 15; *(LAS u32x4*)(Ksm + key * 136 + ch * 8) = kq[i]; vt_scatter<true>(Vt, 264, ch * 8, key, vq[i]); }
    __builtin_amdgcn_sched_barrier(0); }
    __syncthreads();
#pragma unroll 1
    for (int qt = 0; qt < 2; ++qt) { asm volatile("" ::: "memory"); const size_t row = (size_t)b * SEQ + qc * 256 + wave * 32 + qt * 16 + (lane & 15);
        mem_qtile(Ksm, Vt, Z + row * INW + MQO + hm * 128, BR + row * 1536 + 1024 + hm * 128, true, lane); }
    __syncthreads();
}
constexpr int MEMP_S2 = 28, MEMP_S3 = 124, MEMP_S4 = 104;
static_assert(MEMP_S2 + MEMP_S3 + MEMP_S4 == 256, "mem prompt items");

struct PRow { u32x4 qv, kvv, mv; f32x4 r0, r1, r2, r3; };
__device__ __forceinline__ PRow post_load(const bf16* Z, const float* ROPE, int r, int lane) {
    PRow p; const bf16* zr = Z + (size_t)r * INW; const int pidx = (r < MP) ? (r & (SEQ - 1)) : SEQ + ((r - MP) & 3);
    p.qv = *(const u32x4*)(zr + lane * 8); p.kvv = *(const u32x4*)(zr + KO + (lane & 31) * 8); p.mv = *(const u32x4*)(zr + MQO + lane * 8);
    const f32x4* rp = (const f32x4*)(ROPE + (size_t)(pidx * 32 + (lane & 3) * 8) * 2); p.r0 = rp[0]; p.r1 = rp[1]; p.r2 = rp[2]; p.r3 = rp[3];
    return p;
}

template <int ph, bool DRY = false>
__device__ __forceinline__ void run_phase(const Params& P, LAS unsigned char* lds) {
    const int tid = threadIdx.x, lane = tid & 63, wave = __builtin_amdgcn_readfirstlane(tid >> 6);
    const int G = gridDim.x, bid = blockIdx.x;
    const int gw = bid * 8 + wave, NGW = G * 8;
    const int gt = bid * 512 + tid, NGT = G * 512;
    unsigned char* ws = P.ws;
    float* out = P.out;
    bf16* XN = (bf16*)(ws + WS_XN); bf16* Z = (bf16*)(ws + WS_Z); bf16* BR = (bf16*)(ws + WS_BR); bf16* ZS = (bf16*)(ws + WS_ZS);
    bf16* MERGED = (bf16*)(ws + WS_MERGED); bf16* HB = (bf16*)(ws + WS_H); bf16* MEMN = (bf16*)(ws + WS_MEMN); float* KVMEM = (float*)(ws + WS_KVMEM);
    bf16* MK = (bf16*)(ws + WS_MK); bf16* MV = (bf16*)(ws + WS_MV); float* ROPE = (float*)(ws + WS_ROPE);
    float* X = out;

    {
        if constexpr (ph == 0) { if (PHM & 2048) {
            for (int pass = 0; pass < 2; ++pass) {
            if ((pass == 0) == ((bid & 1) != 0)) {
                LAS float* Cre = (LAS float*)lds; LAS float* Cim = Cre + 1024; LAS float* Bsm = Cre + 2048; LAS float* Lsm = Cre + 4096; LAS float* Msm = Cre + 8448;
                for (int it = bid; it < 256; it += G) {
                    const int lg = it >> 2, q = it & 3;
                    for (int e = tid; e < 1024; e += 512) { Cre[e] = P.in[19][(size_t)lg * 1024 + e]; Cim[e] = P.in[20][(size_t)lg * 1024 + e]; }
                    if (tid < 64) { const int p = tid, e = lg * 64 + p;
                        const double are = (double)P.in[14][e], aim = (double)P.in[15][e], dt = exp((double)P.in[16][lg]);
                        const double mag = exp(are * dt); double sn, cs; sincos_d(aim * dt, sn, cs);
                        const double lre = mag * cs, lim = mag * sn, den = are * are + aim * aim, nr = lre - 1.0, ni = lim;
                        const double gre = (nr * are + ni * aim) / den, gim = (ni * are - nr * aim) / den;
                        double qr = 1.0, qi = 0.0;
                        for (int qq = 0; qq <= 32; ++qq) { Lsm[(qq * 64 + p) * 2] = (float)qr; Lsm[(qq * 64 + p) * 2 + 1] = (float)qi; const double a = qr * lre - qi * lim, b = qr * lim + qi * lre; qr = a; qi = b; }
                        const float* bre = P.in[17] + (size_t)e * 16; const float* bim = P.in[18] + (size_t)e * 16;
                        for (int c = 0; c < 16; ++c) { const double br = bre[c], bi = bim[c]; Bsm[p * 32 + c] = (float)(gre * br - gim * bi); Bsm[p * 32 + 16 + c] = (float)(gre * bi + gim * br); } }
                    __syncthreads();
                    { const int tau = tid >> 4, cb = (tid >> 2) & 3, c2b = tid & 3; float o[4][4];
#pragma unroll
                      for (int i = 0; i < 4; ++i)
#pragma unroll
                          for (int jx = 0; jx < 4; ++jx) o[i][jx] = 0.f;
                      for (int p = 0; p < 64; ++p) { const float lr = Lsm[(tau * 64 + p) * 2], li = Lsm[(tau * 64 + p) * 2 + 1]; float clr[4], cli[4];
#pragma unroll
                          for (int i = 0; i < 4; ++i) { const float cr = Cre[(4 * cb + i) * 64 + p], ci = Cim[(4 * cb + i) * 64 + p]; clr[i] = cr * lr - ci * li; cli[i] = cr * li + ci * lr; }
#pragma unroll
                          for (int jx = 0; jx < 4; ++jx) { const float br = Bsm[p * 32 + 4 * c2b + jx], bi = Bsm[p * 32 + 16 + 4 * c2b + jx];
#pragma unroll
                              for (int i = 0; i < 4; ++i) o[i][jx] += clr[i] * br - cli[i] * bi; } }
#pragma unroll
                      for (int i = 0; i < 4; ++i)
#pragma unroll
                          for (int jx = 0; jx < 4; ++jx) Msm[(tau * 16 + 4 * cb + i) * 16 + 4 * c2b + jx] = o[i][jx]; }
                    __syncthreads();
                    bf16* bt2 = (bf16*)(ws + WS_BT2) + (size_t)lg * 512 * 640; bf16* bt1 = (bf16*)(ws + WS_BT1) + (size_t)lg * 256 * 512;
                    for (int k = 0; k < 16; ++k) { const int id = tid + 512 * k, rl = id >> 6, cc = id & 63, t = 8 * q + (rl >> 4), c = rl & 15, sp = cc >> 1, c0 = (cc & 1) * 8;
                        u32x4 w = (u32x4){0u, 0u, 0u, 0u};
                        if (sp <= t) { const LAS float* mp = Msm + ((t - sp) * 16 + c) * 16 + c0; w.x = pk2(mp[0], mp[1]); w.y = pk2(mp[2], mp[3]); w.z = pk2(mp[4], mp[5]); w.w = pk2(mp[6], mp[7]); }
                        *(u32x4*)(bt2 + (size_t)(t * 16 + c) * 640 + sp * 16 + c0) = w; }
                    for (int k = 0; k < 4; ++k) { const int id = tid + 512 * k, rl = id >> 4, cc = id & 15, t = 8 * q + (rl >> 4), c = rl & 15, isim = cc >> 3, p0 = (cc & 7) * 8; float v[8];
#pragma unroll
                        for (int e = 0; e < 8; ++e) { const int p = p0 + e; const float lr = Lsm[((t + 1) * 64 + p) * 2], li = Lsm[((t + 1) * 64 + p) * 2 + 1], cr = Cre[c * 64 + p], ci = Cim[c * 64 + p];
                            v[e] = isim ? -(cr * li + ci * lr) : (cr * lr - ci * li); }
                        u32x4 w; w.x = pk2(v[0], v[1]); w.y = pk2(v[2], v[3]); w.z = pk2(v[4], v[5]); w.w = pk2(v[6], v[7]);
                        *(u32x4*)(bt2 + (size_t)(t * 16 + c) * 640 + 512 + isim * 64 + p0) = w; }
                    for (int k = 0; k < 4; ++k) { const int id = tid + 512 * k, rl = id >> 6, cc = id & 63, sp = cc >> 1, c0 = (cc & 1) * 8, isim = q >> 1, p = (q & 1) * 32 + rl; float v[8];
                        const float lr = Lsm[((31 - sp) * 64 + p) * 2], li = Lsm[((31 - sp) * 64 + p) * 2 + 1];
#pragma unroll
                        for (int e = 0; e < 8; ++e) { const float br = Bsm[p * 32 + c0 + e], bi = Bsm[p * 32 + 16 + c0 + e]; v[e] = isim ? (lr * bi + li * br) : (lr * br - li * bi); }
                        u32x4 w; w.x = pk2(v[0], v[1]); w.y = pk2(v[2], v[3]); w.z = pk2(v[4], v[5]); w.w = pk2(v[6], v[7]);
                        *(u32x4*)(bt1 + (size_t)(isim * 64 + p) * 512 + sp * 16 + c0) = w; }
                    __syncthreads();
                }
            } else {
            LAS float* scr = (LAS float*)(lds + wave * 16640);
            for (int it = gw; it < DEPTH * TI_LAYER; it += NGW) weight_item(P, it, scr, lane);
            for (int m = gw; m < MEMROWS; m += NGW) rms_row_to_bf16(P.in[8] + (size_t)m * DM, MEMN + (size_t)m * DM, lane);
            for (int m = gw; m < MT; m += NGW) rms_row_to_bf16(m < MP ? P.in[0] + (size_t)m * DM : P.in[1] + (size_t)(m - MP) * DM, XN + (size_t)m * DM, lane);
            for (int e = gt; e < MS * DM / 4; e += NGT) ((f32x4*)(X + (size_t)MP * DM))[e] = ((const f32x4*)P.in[1])[e];
            for (int e = gt; e < NPOS * 32; e += NGT) { const int pi = e >> 5, i = e & 31; const double pos = (pi < SEQ) ? (double)pi : (double)(PAST + pi - SEQ);
                double sn, cs; sincos_d(pos * INVF[i], sn, cs); ROPE[2 * e] = (float)cs; ROPE[2 * e + 1] = (float)sn; }
            for (int e = gt; e < DEPTH * 32 * 64; e += NGT) { const int l = e >> 11, g = (e >> 6) & 31, p = e & 63;
                const double are = (double)P.in[14][e], aim = (double)P.in[15][e], dt = exp((double)P.in[16][l * 32 + g]);
                const double mag = exp(are * dt); double sn, cs; sincos_d(aim * dt, sn, cs);
                const double lre = mag * cs, lim = mag * sn, den = are * are + aim * aim, nr = lre - 1.0, ni = lim;
                const double gre = (nr * are + ni * aim) / den, gim = (ni * are - nr * aim) / den;
                double pr = lre, pi2 = lim;
                { float* lp = (float*)(ws + WS_LAMP) + ((size_t)(l * 32 + g) * 33 * 64 + p) * 2; double qr = 1.0, qi = 0.0;
                  for (int q = 0; q <= 32; ++q) { lp[(size_t)q * 128] = (float)qr; lp[(size_t)q * 128 + 1] = (float)qi; const double a = qr * lre - qi * lim, b = qr * lim + qi * lre; qr = a; qi = b; } }
#pragma unroll
                for (int q = 0; q < 5; ++q) { const double a = pr * pr - pi2 * pi2, b = 2.0 * pr * pi2; pr = a; pi2 = b; }
                float* lam = (float*)(ws + WS_LAM) + (size_t)e * 4; lam[0] = (float)lre; lam[1] = (float)lim; lam[2] = (float)pr; lam[3] = (float)pi2;
                float* bp = (float*)(ws + WS_BP) + (size_t)e * 32; const f32x4* bre = (const f32x4*)(P.in[17] + (size_t)e * 16); const f32x4* bim = (const f32x4*)(P.in[18] + (size_t)e * 16);
                const f32x4 r0 = bre[0], r1 = bre[1], r2 = bre[2], r3 = bre[3], i0 = bim[0], i1 = bim[1], i2 = bim[2], i3 = bim[3];
                __builtin_amdgcn_sched_barrier(0);
                const float brv[16] = {r0.x, r0.y, r0.z, r0.w, r1.x, r1.y, r1.z, r1.w, r2.x, r2.y, r2.z, r2.w, r3.x, r3.y, r3.z, r3.w}, biv[16] = {i0.x, i0.y, i0.z, i0.w, i1.x, i1.y, i1.z, i1.w, i2.x, i2.y, i2.z, i2.w, i3.x, i3.y, i3.z, i3.w};
#pragma unroll
                for (int c = 0; c < 16; ++c) { const double br = brv[c], bi = biv[c]; bp[c] = (float)(gre * br - gim * bi); bp[16 + c] = (float)(gre * bi + gim * br); } }
            }
            __syncthreads();
            }
            }
            return;
        }
        constexpr int l = (ph == 0) ? 0 : (ph - 1) / NPS, s = (ph == 0) ? -1 : (ph - 1) % NPS;
        const int off128 = (G == 256) ? 128 : 0;
        bf16* A2 = (bf16*)(ws + WS_A2); float* SS = (float*)(ws + WS_SS); const float* LAMP = (const float*)(ws + WS_LAMP);
        unsigned char* wb = ws + WS_W + (size_t)l * W_LAYER;
        if constexpr (s == 0 && (PHM & 1)) {
            { pg8::Gemm g{XN, (const bf16*)(wb + OFF_WIN), MT, INW, DM, DM, DM}; pg8::StaticOrder S; S.init(MT, INW, G, bid);
              pg8::EpiZ E{Z, INW, GO / 256, A2}; pg8::gemm_phase<pg8::EpiZ, pg8::StaticOrder, true, true>(lds, g, S, E); }
            { pg8::Gemm g{MEMN, (const bf16*)(wb + OFF_WMKV), MEMROWS, 1024, DM, DM, DM}; pg8::StaticOrder S; S.init(MEMROWS, 1024, G, G - 1 - bid);
              pg8::EpiF32 E{KVMEM, 1024}; pg8::gemm_phase<pg8::EpiF32, pg8::StaticOrder, true, true>(lds, g, S, E); }
        } else if constexpr (s == 1 && (PHM & 2)) {
            { pg8::Gemm g{A2, (const bf16*)(ws + WS_BT1) + (size_t)l * 32 * 256 * 512, 16384, 8192, 512, 640, 512}; pg8::GroupOrder S{G, bid, 64, 0};
              pg8::EpiS E{SS}; pg8::gemm_phase<pg8::EpiS, pg8::GroupOrder, true, true>(lds, g, S, E); }
            const float* qn = P.in[11] + l * 64; const float* kn = P.in[12] + l * 64; const float* mqn = P.in[25] + l * 128; const float* mkn = P.in[26] + l * 128;
            const bool bal = (G == 256); const int R1 = bal ? 4 * NGW : MT, gw2 = gw - 512, NGW2 = NGW - 512;
            const f32x4 gq0 = *(const f32x4*)(qn + (lane & 7) * 8), gq1 = *(const f32x4*)(qn + (lane & 7) * 8 + 4);
            const f32x4 gk0 = *(const f32x4*)(kn + (lane & 7) * 8), gk1 = *(const f32x4*)(kn + (lane & 7) * 8 + 4);
            const f32x4 gm0 = *(const f32x4*)(mqn + (lane & 15) * 8), gm1 = *(const f32x4*)(mqn + (lane & 15) * 8 + 4);
            int rr = gw, part2 = 0;
#define NEXT_ROW(dst) do { dst = -1; if (!part2 && rr >= R1) { if (bal && bid >= 64) { part2 = 1; rr = R1 + gw2; } else rr = MT; } if (rr < MT) { dst = rr; rr += part2 ? NGW2 : NGW; } } while (0)
            int rcur; NEXT_ROW(rcur);
            PRow cur; if (rcur >= 0) cur = post_load(Z, ROPE, rcur, lane);
            while (rcur >= 0) {
                int rnext; NEXT_ROW(rnext);
                PRow nxt = cur; if (rnext >= 0) nxt = post_load(Z, ROPE, rnext, lane);
                __builtin_amdgcn_sched_barrier(0);
                const int r = rcur;
                bf16* zr = Z + (size_t)r * INW; bf16* zw = DRY ? BR + (size_t)r * 1536 : zr;
                int ob; float* okp; float* ovp; bool wr_out;
                if (r < MP) { const int t = r & (SEQ - 1), b = r >> 12; wr_out = t >= SEQ - 128; ob = ((l * NB + b) * 128 + (t - (SEQ - 128))) * 128; okp = out + O_KP; ovp = out + O_VP; }
                else { const int rs = r - MP, b = rs >> 2, t = rs & 3; wr_out = true; ob = ((l * DBATCH + b) * 128 + 124 + t) * 128; okp = out + O_KS; ovp = out + O_VS; }
                const u32x4 qv = cur.qv, kvv = cur.kvv, mv = cur.mv; const f32x4 r0 = cur.r0, r1 = cur.r1, r2 = cur.r2, r3 = cur.r3;
                const float cs[8] = {r0.x, r0.z, r1.x, r1.z, r2.x, r2.z, r3.x, r3.z}, sn[8] = {r0.y, r0.w, r1.y, r1.w, r2.y, r2.w, r3.y, r3.w};
                const float gq[8] = {gq0.x, gq0.y, gq0.z, gq0.w, gq1.x, gq1.y, gq1.z, gq1.w}, gk[8] = {gk0.x, gk0.y, gk0.z, gk0.w, gk1.x, gk1.y, gk1.z, gk1.w}, gm[8] = {gm0.x, gm0.y, gm0.z, gm0.w, gm1.x, gm1.y, gm1.z, gm1.w};
                const bool hi_half = (lane & 4) != 0;
                {
                    float x[8] = {lo16(qv.x), hi16(qv.x), lo16(qv.y), hi16(qv.y), lo16(qv.z), hi16(qv.z), lo16(qv.w), hi16(qv.w)}; float ss = 0.f;
#pragma unroll
                    for (int j = 0; j < 8; ++j) ss = fmaf(x[j], x[j], ss);
                    ss += __shfl_xor(ss, 1); ss += __shfl_xor(ss, 2); ss += __shfl_xor(ss, 4);
                    const float rs = 1.0f / sqrtf(ss * (1.f / 64.f) + EPS); float o[8];
#pragma unroll
                    for (int j = 0; j < 8; ++j) { const float vn = x[j] * rs * gq[j]; const float pt = __shfl_xor(vn, 4); o[j] = hi_half ? vn * cs[j] + pt * sn[j] : vn * cs[j] - pt * sn[j]; }
                    u32x4 w; w.x = pk2(o[0], o[1]); w.y = pk2(o[2], o[3]); w.z = pk2(o[4], o[5]); w.w = pk2(o[6], o[7]); *(u32x4*)(zw + lane * 8) = w; }
                {
                    float x[8] = {lo16(kvv.x), hi16(kvv.x), lo16(kvv.y), hi16(kvv.y), lo16(kvv.z), hi16(kvv.z), lo16(kvv.w), hi16(kvv.w)}; float ss = 0.f;
#pragma unroll
                    for (int j = 0; j < 8; ++j) ss = fmaf(x[j], x[j], ss);
                    ss += __shfl_xor(ss, 1); ss += __shfl_xor(ss, 2); ss += __shfl_xor(ss, 4);
                    const float rs = 1.0f / sqrtf(ss * (1.f / 64.f) + EPS); float o[8];
#pragma unroll
                    for (int j = 0; j < 8; ++j) { const float vn = x[j] * rs * gk[j]; const float pt = __shfl_xor(vn, 4); o[j] = hi_half ? vn * cs[j] + pt * sn[j] : vn * cs[j] - pt * sn[j]; }
                    if (lane < 16) { u32x4 w; w.x = pk2(o[0], o[1]); w.y = pk2(o[2], o[3]); w.z = pk2(o[4], o[5]); w.w = pk2(o[6], o[7]); *(u32x4*)(zw + KO + lane * 8) = w;
                        if (wr_out) { *(f32x4*)(okp + (size_t)ob + lane * 8) = (f32x4){o[0], o[1], o[2], o[3]}; *(f32x4*)(okp + (size_t)ob + lane * 8 + 4) = (f32x4){o[4], o[5], o[6], o[7]}; } }
                    else if (lane < 32 && wr_out) { *(f32x4*)(ovp + (size_t)ob + (lane - 16) * 8) = (f32x4){x[0], x[1], x[2], x[3]}; *(f32x4*)(ovp + (size_t)ob + (lane - 16) * 8 + 4) = (f32x4){x[4], x[5], x[6], x[7]}; } }
                {
                    float x[8] = {lo16(mv.x), hi16(mv.x), lo16(mv.y), hi16(mv.y), lo16(mv.z), hi16(mv.z), lo16(mv.w), hi16(mv.w)}; float ss = 0.f;
#pragma unroll
                    for (int j = 0; j < 8; ++j) ss = fmaf(x[j], x[j], ss);
                    ss += __shfl_xor(ss, 1); ss += __shfl_xor(ss, 2); ss += __shfl_xor(ss, 4); ss += __shfl_xor(ss, 8);
                    const float rs = 1.0f / sqrtf(ss * (1.f / 128.f) + EPS);
                    u32x4 w; w.x = pk2(x[0] * rs * gm[0], x[1] * rs * gm[1]); w.y = pk2(x[2] * rs * gm[2], x[3] * rs * gm[3]); w.z = pk2(x[4] * rs * gm[4], x[5] * rs * gm[5]); w.w = pk2(x[6] * rs * gm[6], x[7] * rs * gm[7]);
                    *(u32x4*)(zw + (DRY ? 640 : MQO) + lane * 8) = w; }
                cur = nxt; rcur = rnext;
            }
#undef NEXT_ROW
            for (int mr = (bal ? (bid >= 64 ? gw - 512 : MEMROWS) : gw); mr < MEMROWS; mr += (bal ? NGW - 512 : NGW)) {
                const float* src = KVMEM + (size_t)mr * 1024; float* ok = out + O_MKP + ((size_t)l * MEMROWS + mr) * 512; float* ov = out + O_MVP + ((size_t)l * MEMROWS + mr) * 512;
                float kx[8], vx[8];
#pragma unroll
                for (int i = 0; i < 8; ++i) { kx[i] = src[i * 64 + lane]; vx[i] = src[512 + i * 64 + lane]; }
                __builtin_amdgcn_sched_barrier(0);
#pragma unroll
                for (int hm = 0; hm < 4; ++hm) { const float a = kx[2 * hm], b2 = kx[2 * hm + 1];
                    const float ss = wave_sum(a * a + b2 * b2); const float rs = 1.0f / sqrtf(ss * (1.f / 128.f) + EPS);
                    const float ka = a * rs * mkn[lane], kb = b2 * rs * mkn[64 + lane];
                    ok[hm * 128 + lane] = ka; ok[hm * 128 + 64 + lane] = kb; MK[(size_t)mr * 512 + hm * 128 + lane] = (bf16)f2bf(ka); MK[(size_t)mr * 512 + hm * 128 + 64 + lane] = (bf16)f2bf(kb); }
#pragma unroll
                for (int i = 0; i < 8; ++i) { ov[i * 64 + lane] = vx[i]; MV[(size_t)mr * 512 + i * 64 + lane] = (bf16)f2bf(vx[i]); }
            }
            { const f32x4* ck = (const f32x4*)(P.in[2] + (size_t)l * DBATCH * 128 * 128); const f32x4* cv = (const f32x4*)(P.in[3] + (size_t)l * DBATCH * 128 * 128);
              f32x4* dk = (f32x4*)(out + O_KS + (size_t)l * DBATCH * 128 * 128); f32x4* dv = (f32x4*)(out + O_VS + (size_t)l * DBATCH * 128 * 128);
              for (int e = gt; e < DBATCH * 124 * 32; e += 2 * NGT) { const int e2 = e + NGT; const bool ok2 = e2 < DBATCH * 124 * 32; const int b = e / (124 * 32), rem = e % (124 * 32), b2 = ok2 ? e2 / (124 * 32) : b, rem2 = ok2 ? e2 % (124 * 32) : rem;
                  const f32x4 k0 = ck[b * 4096 + 128 + rem], v0 = cv[b * 4096 + 128 + rem], k1 = ck[b2 * 4096 + 128 + rem2], v1 = cv[b2 * 4096 + 128 + rem2];
                  __builtin_amdgcn_sched_barrier(0);
                  dk[b * 4096 + rem] = k0; dv[b * 4096 + rem] = v0; if (ok2) { dk[b2 * 4096 + rem2] = k1; dv[b2 * 4096 + rem2] = v1; } } }
        } else if constexpr (s == 2 && (PHM & 4)) {
            const bool balI = (G == 256); int nsamp = 0, js0 = 0, js1 = 0, js2 = 0;
            if (balI) { if (bid < 16) { nsamp = 1; js0 = 240 + bid; } else if (bid < 60) { nsamp = 3; js0 = bid - 16; js1 = 240 + bid; js2 = (bid < 44) ? 196 + bid : 452 + bid; }
                        else if (bid < 228) { nsamp = 2; js0 = bid - 16; js1 = 240 + bid; } else { nsamp = 1; js0 = 240 + bid; } }
            const int nk_main = ((balI ? 1296 : 1296 + 512) - 1 - bid) / G + 1, nk_items = nk_main + nsamp;
            for (int kk = 0; kk < nk_items; ++kk) { const int slot = (bid & 1) ? (nk_items - 1 - kk) : kk; int it;
                if (slot < nk_main) it = bid + slot * G; else { const int q = slot - nk_main; it = 1296 + (q == 0 ? js0 : (q == 1 ? js1 : js2)); }
              for (int rep = 0; rep < ((it < 1280) ? REP_ATT : REP_SSM2); ++rep) { asm volatile("" ::: "memory");
                if (it < 256) { if (ITM & 1) {
                    const int kvh = it & 1, blk = (it >> 1) & 31, b = it >> 6;
                    LAS bf16* Ksm = (LAS bf16*)lds; LAS bf16* Vt = (LAS bf16*)(lds + 256 * 72 * 2);
                    { u32x4 kq[4], vq[4];
#pragma unroll
                    for (int i = 0; i < 4; ++i) { const int cid = tid + 512 * i, key = cid >> 3, ch = cid & 7; const int trow = (blk - 1) * 128 + key;
                        kq[i] = (u32x4){0u, 0u, 0u, 0u}; vq[i] = kq[i];
                        if (trow >= 0) { const bf16* zr = Z + (size_t)(b * SEQ + trow) * INW; kq[i] = *(const u32x4*)(zr + KO + kvh * 64 + ch * 8); vq[i] = *(const u32x4*)(zr + VO + kvh * 64 + ch * 8); } }
                    __builtin_amdgcn_sched_barrier(0);
#pragma unroll
                    for (int i = 0; i < 4; ++i) { const int cid = tid + 512 * i, key = cid >> 3, ch = cid & 7;
                        *(LAS u32x4*)(Ksm + key * 72 + ch * 8) = kq[i]; vt_scatter<false>(Vt, 264, ch * 8, key, vq[i]); }
                    __builtin_amdgcn_sched_barrier(0); }
                    __syncthreads();
                    const int gq = wave >> 1, qh = wave & 1, hq = kvh * 4 + gq; const float sink = P.in[13][l * 8 + hq];
#pragma unroll 1
                    for (int qt = 0; qt < 4; ++qt) { asm volatile("" ::: "memory"); const int i0 = qh * 64 + qt * 16; const size_t row = (size_t)b * SEQ + blk * 128 + i0 + (lane & 15);
                        swa_qtile<0>(Ksm, Vt, (i0 >> 4) < 6 ? (i0 >> 4) : 6, Z + row * INW + hq * 64, sink, i0 + (lane & 15), blk > 0 ? 0 : 128, BR + row * 1536 + hq * 64, lane); }
                    __syncthreads();
                } } else if (it < 512) { if (ITM & 2) {
                    const int i2 = it - 256, kvh = i2 & 1, b = i2 >> 1;
                    LAS bf16* Ksm = (LAS bf16*)lds; LAS bf16* Vt = (LAS bf16*)(lds + 256 * 72 * 2);
                    { f32x4 kf[3][2], vf[3][2]; u32x4 kz[3], vz[3];
#pragma unroll
                    for (int i = 0; i < 3; ++i) { const int cid = tid + 512 * i, key = cid >> 3, ch = cid & 7;
                        kf[i][0] = kf[i][1] = vf[i][0] = vf[i][1] = (f32x4){0.f, 0.f, 0.f, 0.f}; kz[i] = vz[i] = (u32x4){0u, 0u, 0u, 0u};
                        if (key < 128) { const size_t so = ((((size_t)l * DBATCH + b) * 128 + key) * 2 + kvh) * 64 + ch * 8;
                            kf[i][0] = *(const f32x4*)(P.in[2] + so); kf[i][1] = *(const f32x4*)(P.in[2] + so + 4); vf[i][0] = *(const f32x4*)(P.in[3] + so); vf[i][1] = *(const f32x4*)(P.in[3] + so + 4); }
                        else if (key < 132) { const bf16* zr = Z + (size_t)(MP + b * 4 + key - 128) * INW; kz[i] = *(const u32x4*)(zr + KO + kvh * 64 + ch * 8); vz[i] = *(const u32x4*)(zr + VO + kvh * 64 + ch * 8); } }
                    __builtin_amdgcn_sched_barrier(0);
#pragma unroll
                    for (int i = 0; i < 3; ++i) { const int cid = tid + 512 * i; if (cid < 1280) { const int key = cid >> 3, ch = cid & 7;
                        u32x4 kv = kz[i], vv = vz[i];
                        if (key < 128) { kv.x = pk2(kf[i][0].x, kf[i][0].y); kv.y = pk2(kf[i][0].z, kf[i][0].w); kv.z = pk2(kf[i][1].x, kf[i][1].y); kv.w = pk2(kf[i][1].z, kf[i][1].w);
                            vv.x = pk2(vf[i][0].x, vf[i][0].y); vv.y = pk2(vf[i][0].z, vf[i][0].w); vv.z = pk2(vf[i][1].x, vf[i][1].y); vv.w = pk2(vf[i][1].z, vf[i][1].w); }
                        *(LAS u32x4*)(Ksm + key * 72 + ch * 8) = kv; vt_scatter<false>(Vt, 264, ch * 8, key, vv); } }
                    __builtin_amdgcn_sched_barrier(0); }
                    __syncthreads();
                    if (wave == 0) { const int lq = lane & 15, t = lq >> 2, gq = lq & 3, hq = kvh * 4 + gq; const size_t row = (size_t)MP + b * 4 + t;
                        swa_qtile<1>(Ksm, Vt, 0, Z + row * INW + hq * 64, P.in[13][l * 8 + hq], 0, 0, BR + row * 1536 + hq * 64, lane); }
                    __syncthreads();
                } } else if (it < 768) { if (ITM & 4) {
                    if (it - 512 >= 256 - MEMP_S2) mem_prompt_item(it - 512 - (256 - MEMP_S2), Z, MK, MV, BR, lds, tid, wave, lane);
                } } else if (it < 1280) { if (ITM & 8) {
                    const int i2 = it - 768, hm = i2 & 3, b = i2 >> 2;
                    LAS bf16* Ksm = (LAS bf16*)lds; LAS bf16* Vt = (LAS bf16*)(lds + 256 * 136 * 2);
#pragma unroll
                    for (int hb = 0; hb < 2; ++hb) { f32x4 kf[4][2], vf[4][2];
#pragma unroll
                        for (int i = 0; i < 4; ++i) { const int cid = tid + 512 * (4 * hb + i), key = cid >> 4, ch = cid & 15; const size_t so = ((((size_t)l * DBATCH + b) * NMEM + key) * 4 + hm) * 128 + ch * 8;
                            kf[i][0] = *(const f32x4*)(P.in[6] + so); kf[i][1] = *(const f32x4*)(P.in[6] + so + 4); vf[i][0] = *(const f32x4*)(P.in[7] + so); vf[i][1] = *(const f32x4*)(P.in[7] + so + 4); }
                        __builtin_amdgcn_sched_barrier(0);
#pragma unroll
                        for (int i = 0; i < 4; ++i) { const int cid = tid + 512 * (4 * hb + i), key = cid >> 4, ch = cid & 15; u32x4 kv, vv;
                            kv.x = pk2(kf[i][0].x, kf[i][0].y); kv.y = pk2(kf[i][0].z, kf[i][0].w); kv.z = pk2(kf[i][1].x, kf[i][1].y); kv.w = pk2(kf[i][1].z, kf[i][1].w);
                            vv.x = pk2(vf[i][0].x, vf[i][0].y); vv.y = pk2(vf[i][0].z, vf[i][0].w); vv.z = pk2(vf[i][1].x, vf[i][1].y); vv.w = pk2(vf[i][1].z, vf[i][1].w);
                            *(LAS u32x4*)(Ksm + key * 136 + ch * 8) = kv; vt_scatter<true>(Vt, 264, ch * 8, key, vv); }
                        __builtin_amdgcn_sched_barrier(0); }
                    __syncthreads();
                    if (wave == 0) { const int lq = lane & 15; const size_t row = (size_t)MP + b * 4 + (lq & 3);
                        mem_qtile(Ksm, Vt, Z + row * INW + MQO + hm * 128, BR + row * 1536 + 1024 + hm * 128, lq < 4, lane); }
                    __syncthreads();
                } } else if (it < 1296) { if (ITM & 16) {
                    const int wi = (it - 1280) * 8 + wave, g = wi & 31, b = wi >> 5;
                    const float l32r = LAMP[((size_t)(l * 32 + g) * 33 + 32) * 128 + lane * 2], l32i = LAMP[((size_t)(l * 32 + g) * 33 + 32) * 128 + lane * 2 + 1];
                    const float* ssp = SS + (size_t)(g * 512 + b * 128) * 128 + lane; bf16* hs = A2 + (size_t)(g * 512 + b * 128) * 640 + 512 + lane;
                    float hr = 0.f, hi = 0.f;
#pragma unroll 1
                    for (int j0 = 0; j0 < 128; j0 += 16) { float sr[16], si[16];
#pragma unroll
                        for (int j = 0; j < 16; ++j) { sr[j] = ssp[(size_t)(j0 + j) * 128]; si[j] = ssp[(size_t)(j0 + j) * 128 + 64]; }
                        __builtin_amdgcn_sched_barrier(0);
#pragma unroll
                        for (int j = 0; j < 16; ++j) { hs[(size_t)(j0 + j) * 640] = (bf16)f2bf(hr); hs[(size_t)(j0 + j) * 640 + 64] = (bf16)f2bf(hi);
                            const float nr = fmaf(l32r, hr, fmaf(-l32i, hi, sr[j])), ni = fmaf(l32r, hi, fmaf(l32i, hr, si[j])); hr = nr; hi = ni; }
                        __builtin_amdgcn_sched_barrier(0); }
                    const size_t oo = (((size_t)l * NB + b) * 32 + g) * 64 + lane; out[O_HRP + oo] = hr; out[O_HIP + oo] = hi;
                } } else { if (ITM & 16) {
                    const int wi = (it - 1296) * 8 + wave, g = wi & 31, b = wi >> 5; const size_t row0 = (size_t)MP + b * 4;
                    const int e = (l * 32 + g) * 64 + lane; const f32x4 lam = *(const f32x4*)((const float*)(ws + WS_LAM) + (size_t)e * 4);
                    const size_t so = (((size_t)l * DBATCH + b) * 32 + g) * 64 + lane; float hr = P.in[4][so], hi = P.in[5][so];
                    float br[16], bi[16], cr[16], ci[16];
                    { const f32x4* bp = (const f32x4*)((const float*)(ws + WS_BP) + (size_t)e * 32);
#pragma unroll
                      for (int q = 0; q < 4; ++q) { const f32x4 a = bp[q], b4 = bp[4 + q]; br[4 * q] = a.x; br[4 * q + 1] = a.y; br[4 * q + 2] = a.z; br[4 * q + 3] = a.w; bi[4 * q] = b4.x; bi[4 * q + 1] = b4.y; bi[4 * q + 2] = b4.z; bi[4 * q + 3] = b4.w; } }
                    { const float* cre = P.in[19] + ((size_t)(l * 32 + g) * 16) * 64 + lane; const float* cim = P.in[20] + ((size_t)(l * 32 + g) * 16) * 64 + lane;
#pragma unroll
                      for (int q = 0; q < 16; ++q) { cr[q] = cre[q * 64]; ci[q] = cim[q * 64]; } }
                    const float dcl = P.in[21][l * 512 + g * 16 + (lane >> 2)];
                    ssm_run<true, 4>(Z + row0 * INW + UO + g * 16, 4, lam.x, lam.y, br, bi, hr, hi, cr, ci, dcl, ZS + row0 * 512 + g * 16 + (lane >> 2), lane);
                    out[O_HRS + so] = hr; out[O_HIS + so] = hi;
                } }
              }
            }
        } else if constexpr (s == 3 && (PHM & 8)) {
            pg8::Gemm g{A2, (const bf16*)(ws + WS_BT2) + (size_t)l * 32 * 512 * 640, 16384, 16384, 640, 640, 640}; pg8::GroupOrder S{G, bid, 128, 1};
            pg8::EpiY E{A2, P.in[21] + l * 512, ZS}; pg8::gemm_phase<pg8::EpiY, pg8::GroupOrder, true, true>(lds, g, S, E);
            { pg8::Gemm g2{ZS, (const bf16*)(wb + OFF_WGLU), MT, 512, 512, 512, 512}; pg8::RangeOrder S2{G, bid - off128, 64, 2, 2};
              pg8::EpiGlu E2{ZS, BR}; pg8::gemm_phase<pg8::EpiGlu, pg8::RangeOrder, true, true>(lds, g2, S2, E2); }
            if (G == 256 && bid >= 256 - MEMP_S3) mem_prompt_item(MEMP_S2 + bid - (256 - MEMP_S3), Z, MK, MV, BR, lds, tid, wave, lane);
            else if (G != 256) { for (int i2 = MEMP_S2 + bid; i2 < MEMP_S2 + MEMP_S3; i2 += G) mem_prompt_item(i2, Z, MK, MV, BR, lds, tid, wave, lane); }
        } else if constexpr (s == 4 && (PHM & 16)) {
            { pg8::Gemm g{ZS, (const bf16*)(wb + OFF_WGLU), MP, 512, 512, 512, 512}; pg8::StaticOrder S; S.init(MP, 512, G, bid);
              pg8::EpiGlu E{ZS, BR}; pg8::gemm_phase<pg8::EpiGlu, pg8::StaticOrder, true, true>(lds, g, S, E); }
            { pg8::Gemm g{BR, (const bf16*)(wb + OFF_WBR), MT, DM, 512, 1536, 1536}; pg8::TailOrder S{bid - off128, 3, 1024, G};
              pg8::EpiGatePart E{Z, (float*)(ws + WS_PART)}; pg8::gemm_phase<pg8::EpiGatePart, pg8::TailOrder, true, true>(lds, g, S, E); }
            if (G == 256 && bid >= 256 - MEMP_S4) mem_prompt_item(MEMP_S2 + MEMP_S3 + bid - (256 - MEMP_S4), Z, MK, MV, BR, lds, tid, wave, lane);
            else if (G != 256) { for (int i2 = MEMP_S2 + MEMP_S3 + bid; i2 < 256; i2 += G) mem_prompt_item(i2, Z, MK, MV, BR, lds, tid, wave, lane); }
        } else if constexpr (s == 5 && (PHM & 32)) {
            pg8::Gemm g{BR, (const bf16*)(wb + OFF_WBR), MP, DM, 1536, 1536, 1536}; pg8::StaticOrder S; S.init(MP, DM, G, bid);
            pg8::EpiMerge E{Z, MERGED}; pg8::gemm_phase<pg8::EpiMerge, pg8::StaticOrder, true, true>(lds, g, S, E);
            for (int e = gt; e < MS * DM / 4; e += NGT) { const f32x4* pp = (const f32x4*)(ws + WS_PART) + e; const f32x4 v = pp[0] + pp[MS * DM / 4] + pp[2 * (MS * DM / 4)];
                u32x2 w; w.x = pk2(v.x, v.y); w.y = pk2(v.z, v.w); *(u32x2*)(MERGED + (size_t)MP * DM + (size_t)e * 4) = w; }
        } else if constexpr (s == 6 && (PHM & 64)) {
            { pg8::Gemm g{MERGED, (const bf16*)(wb + OFF_WOUT), MP, DM, DM, DM, DM}; pg8::StaticOrder S; S.init(MP, DM, G, bid);
              pg8::EpiRes E{l == 0 ? P.in[0] : X, l == 0 ? P.in[1] : X + (size_t)MP * DM, X, DM}; pg8::gemm_phase<pg8::EpiRes, pg8::StaticOrder, true, true>(lds, g, S, E); }
            { pg8::Gemm g{MERGED, (const bf16*)(wb + OFF_WOUT), MT, DM, 256, DM, DM}; pg8::TailOrder S{G - 1 - bid, 4, 512, G};
              pg8::EpiPart E{(float*)(ws + WS_PART), 512}; pg8::gemm_phase<pg8::EpiPart, pg8::TailOrder, true, true>(lds, g, S, E); }
        } else if constexpr ((s == 7 || s == 10) && (PHM & 128)) {
            constexpr bool last_ph = (ph == NPHASE - 1);
            for (int m = (last_ph ? MP + gw : gw); m < MT; m += NGW) { if (m < MP) rms_row_to_bf16(X + (size_t)m * DM, XN + (size_t)m * DM, lane);
                else rms_row_to_bf16(X + (size_t)m * DM, XN + (size_t)m * DM, lane, (const float*)(ws + WS_PART) + (size_t)(m - MP) * DM, s == 7 ? 4 : 11, X + (size_t)m * DM, !last_ph); }
        } else if constexpr (s == 8 && (PHM & 256)) {
            pg8::Gemm g{XN, (const bf16*)(wb + OFF_WUP), MT, 2 * DFF, DM, DM, DM}; pg8::StaticOrder S; S.init(MT, 2 * DFF, G, bid);
            pg8::EpiSwiglu E{HB}; pg8::gemm_phase<pg8::EpiSwiglu, pg8::StaticOrder, true, true>(lds, g, S, E);
        } else if constexpr (s == 9 && (PHM & 512)) {
            { pg8::Gemm g{HB, (const bf16*)(wb + OFF_WDN), MP, DM, DFF, DFF, DFF}; pg8::StaticOrder S; S.init(MP, DM, G, bid);
              pg8::EpiRes E{X, X + (size_t)MP * DM, DRY ? (float*)(ws + WS_MERGED) : X, DM}; pg8::gemm_phase<pg8::EpiRes, pg8::StaticOrder, true, true>(lds, g, S, E); }
            { pg8::Gemm g{HB, (const bf16*)(wb + OFF_WDN), MT, DM, 256, DFF, DFF}; pg8::TailOrder S{G - 1 - bid, 11, 512, G};
              pg8::EpiPart E{(float*)(ws + WS_PART), 512}; pg8::gemm_phase<pg8::EpiPart, pg8::TailOrder, true, true>(lds, g, S, E); }
        }
    }
}

#define XB_TMO      128
#define XB_XCNT(j)  (256  + 64 * (j))
#define XB_XSUB(j)  (1280 + 64 * (j))
#define XB_XGEN(j)  (2304 + 64 * (j))
#define XB_TOP      3328
#define XB_TOPGEN   3392
#define XCD_BAR_WORDS 3456
#define XB_SPIN_CAP (1u << 18)
__device__ __forceinline__ unsigned xb_ld(unsigned* p)              { return __hip_atomic_load(p, __ATOMIC_RELAXED, __HIP_MEMORY_SCOPE_AGENT); }
__device__ __forceinline__ unsigned xb_add(unsigned* p, unsigned v) { return __hip_atomic_fetch_add(p, v, __ATOMIC_RELAXED, __HIP_MEMORY_SCOPE_AGENT); }
__device__ __forceinline__ unsigned xb_xcc_id() { return (unsigned)__builtin_amdgcn_s_getreg((3 << 11) | 20) & 0xFu; }
#define XB_SPIN(cond, bar) do { unsigned _sp = 0; while (cond) { __builtin_amdgcn_s_sleep(1); \
    if ((++_sp & 255u) == 0u) { if (xb_ld(&(bar)[XB_TMO])) break; if (_sp > XB_SPIN_CAP) { atomicAdd(&(bar)[XB_TMO], 1u); break; } } } } while (0)
struct XcdBarrier { unsigned* bar; unsigned x; volatile LAS unsigned* st; };
__device__ __forceinline__ XcdBarrier xcd_barrier_post(unsigned* bar, volatile LAS unsigned* st) {
    XcdBarrier b; b.bar = bar; b.x = xb_xcc_id(); b.st = st;
    if (threadIdx.x == 0) (void)xb_add(&bar[XB_XCNT(b.x)], 1u);
    return b;
}
__device__ __forceinline__ void xcd_barrier_complete(unsigned* bar, unsigned x, unsigned& nloc, unsigned& nx) {
    const unsigned G = gridDim.x * gridDim.y * gridDim.z;
    unsigned sum, cnt, mine, sp = 0u;
    for (;;) {
        sum = 0u; cnt = 0u; mine = 0u;
#pragma unroll
        for (unsigned j = 0; j < 16; ++j) { const unsigned c = xb_ld(&bar[XB_XCNT(j)]); sum += c; cnt += (c > 0u) ? 1u : 0u; mine = (j == x) ? c : mine; }
        if (sum == G) break;
        __builtin_amdgcn_s_sleep(1);
        if ((++sp & 255u) == 0u) { if (xb_ld(&bar[XB_TMO])) break; if (sp > XB_SPIN_CAP) { atomicAdd(&bar[XB_TMO], 1u); break; } }
    }
    nloc = mine > 0u ? mine : 1u; nx = cnt > 0u ? cnt : 1u;
}
__device__ __forceinline__ void xcd_barrier(const XcdBarrier& b) {
    asm volatile("s_waitcnt vmcnt(0)" ::: "memory");
    __syncthreads();
    if (threadIdx.x == 0) {
        unsigned* bar = b.bar;
        __builtin_amdgcn_s_waitcnt(0);
        unsigned nloc = b.st[0], nx = b.st[1];
        if (nloc == 0u) { xcd_barrier_complete(bar, b.x, nloc, nx); b.st[0] = nloc; b.st[1] = nx; }
        const unsigned old = xb_add(&bar[XB_XSUB(b.x)], 1u);
        const unsigned gen = old / nloc;
        if (old + 1u == (gen + 1u) * nloc) {
            __builtin_amdgcn_fence(__ATOMIC_RELEASE, "agent");
            asm volatile("s_waitcnt vmcnt(0)" ::: "memory");
            const unsigned og = xb_add(&bar[XB_TOP], 1u);
            const unsigned tg = og / nx;
            if (og + 1u == (tg + 1u) * nx) xb_add(&bar[XB_TOPGEN], 1u);
            else XB_SPIN(xb_ld(&bar[XB_TOPGEN]) == tg, bar);
            __builtin_amdgcn_fence(__ATOMIC_ACQUIRE, "agent");
            xb_add(&bar[XB_XGEN(b.x)], 1u);
            asm volatile("s_waitcnt vmcnt(0)" ::: "memory");
        } else {
            XB_SPIN(xb_ld(&bar[XB_XGEN(b.x)]) == gen, bar);
            __builtin_amdgcn_fence(__ATOMIC_ACQUIRE, "agent");
            asm volatile("s_waitcnt vmcnt(0)" ::: "memory");
        }
    }
    __syncthreads();
}
constexpr int LDS_BAR_OFF = 147456 - 64;

__global__ void __launch_bounds__(512, 2) fwd_kernel(Params P) {
    extern __shared__ __attribute__((aligned(16))) unsigned char lds_raw[];
    LAS unsigned char* lds = (LAS unsigned char*)lds_raw;
    volatile LAS unsigned* bst = (volatile LAS unsigned*)(lds + LDS_BAR_OFF);
    if (threadIdx.x < 2) bst[threadIdx.x] = 0u;
    __syncthreads();
    XcdBarrier xbar; xbar.bar = (unsigned*)P.ws; xbar.x = 0; xbar.st = bst;
    if (P.ph_hi - P.ph_lo > 1) xbar = xcd_barrier_post((unsigned*)P.ws, bst);
    if (P.ph_hi < 0) cg::this_grid().sync();
#define RUNPH(I) if (P.ph_lo <= (I) && (I) < P.ph_hi) { if ((I) > P.ph_lo) xcd_barrier(xbar); run_phase<(I)>(P, lds); }
    RUNPH(0) RUNPH(1) RUNPH(2) RUNPH(3) RUNPH(4) RUNPH(5) RUNPH(6) RUNPH(7) RUNPH(8) RUNPH(9)
    RUNPH(10) RUNPH(11) RUNPH(12) RUNPH(13) RUNPH(14) RUNPH(15) RUNPH(16) RUNPH(17) RUNPH(18) RUNPH(19)
    RUNPH(20) RUNPH(21) RUNPH(22)
    static_assert(NPHASE == 23, "phase list");
#undef RUNPH
}

extern "C" void kernel_launch(void* const* d_in, const int* in_sizes, int n_in, void* d_out, int out_size, void* d_ws, size_t ws_size, hipStream_t stream) {
    static int grid = 0;
    if (grid == 0) {
        if (n_in != 32 || out_size != (int)O_END || ws_size < WS_END) { fprintf(stderr, "kernel_launch: unexpected shapes: n_in %d out %d ws %zu\n", n_in, out_size, ws_size); grid = -1; return; }
        int dev = 0, cus = 0, per_cu = 0;
        hipGetDevice(&dev); hipDeviceGetAttribute(&cus, hipDeviceAttributeMultiprocessorCount, dev);
        if (hipFuncSetAttribute((const void*)fwd_kernel, hipFuncAttributeMaxDynamicSharedMemorySize, LDS_BYTES) != hipSuccess) { fprintf(stderr, "kernel_launch: hipFuncSetAttribute failed\n"); grid = -1; return; }
        if (hipOccupancyMaxActiveBlocksPerMultiprocessor(&per_cu, (const void*)fwd_kernel, 512, LDS_BYTES) != hipSuccess || per_cu < 1) { fprintf(stderr, "kernel_launch: occupancy query says %d\n", per_cu); per_cu = 1; }
        (void)hipGetLastError();
        grid = cus * 1;
        if (grid <= 0) grid = 256;
    }
    if (grid < 0) return;
    Params p{};
    for (int i = 0; i < 32; ++i) p.in[i] = (const float*)d_in[i];
    p.out = (float*)d_out; p.ws = (unsigned char*)d_ws;
#if ONE_LAUNCH
    p.ph_lo = 0; p.ph_hi = NPHASE;
    if (hipMemsetAsync(d_ws, 0, 16384, stream) != hipSuccess) { fprintf(stderr, "kernel_launch: memset of barrier words failed\n"); return; }
    void* args[] = {&p};
    hipError_t e = hipLaunchCooperativeKernel((const void*)fwd_kernel, dim3(grid), dim3(512), args, LDS_BYTES, stream);
    if (e != hipSuccess) fprintf(stderr, "cooperative launch failed: %s (grid %d)\n", hipGetErrorString(e), grid);
#else
    for (int ph = 0; ph < NPHASE; ++ph) { p.ph_lo = ph; p.ph_hi = ph + 1; hipLaunchKernelGGL(fwd_kernel, dim3(grid), dim3(512), LDS_BYTES, stream, p); }
#endif
}
```

```cpp
#include <hip/hip_runtime.h>
#include <hip/hip_cooperative_groups.h>
#include <cstdio>
#include <cstdint>
namespace cg = cooperative_groups;

#ifndef PHM
#define PHM 4095
#endif
#ifndef ITM
#define ITM 31
#endif
#ifndef REP_ATT
#define REP_ATT 1
#endif
#ifndef REP_SSM1
#define REP_SSM1 1
#endif
#ifndef REP_SSM2
#define REP_SSM2 1
#endif
#ifndef ONE_LAUNCH
#define ONE_LAUNCH 1
#endif

#define LAS __attribute__((address_space(3)))
typedef unsigned short bf16;
typedef short bf16x8 __attribute__((ext_vector_type(8)));
typedef short s16x4 __attribute__((ext_vector_type(4)));
typedef float f32x4 __attribute__((ext_vector_type(4)));
typedef unsigned u32x4 __attribute__((ext_vector_type(4)));
typedef unsigned u32x2 __attribute__((ext_vector_type(2)));

constexpr int DM = 1024, NB = 4, SEQ = 4096, DEPTH = 2, DBATCH = 128, DSEQ = 4;
constexpr int MP = NB * SEQ, MS = DBATCH * DSEQ, MT = MP + MS;
constexpr int INW = 4864, KO = 512, VO = 640, UO = 768, MQO = 1280, GO = 1792;
constexpr int DFF = 2816, NMEM = 256, MEMROWS = NB * NMEM;
constexpr float EPS = 1e-6f;
constexpr int NPOS = SEQ + DSEQ;
constexpr int PAST = 16384;

constexpr size_t O_YP = 0, O_YS = O_YP + (size_t)MP * DM, O_KP = O_YS + (size_t)MS * DM, O_VP = O_KP + 2 * 4 * 128 * 128,
                 O_HRP = O_VP + 2 * 4 * 128 * 128, O_HIP = O_HRP + 2 * 4 * 32 * 64, O_MKP = O_HIP + 2 * 4 * 32 * 64,
                 O_MVP = O_MKP + (size_t)2 * 4 * 256 * 512, O_KS = O_MVP + (size_t)2 * 4 * 256 * 512, O_VS = O_KS + (size_t)2 * 128 * 128 * 128,
                 O_HRS = O_VS + (size_t)2 * 128 * 128 * 128, O_HIS = O_HRS + (size_t)2 * 128 * 32 * 64, O_END = O_HIS + (size_t)2 * 128 * 32 * 64;

constexpr size_t MiB = 1u << 20;
constexpr size_t WS_ROPE = 1 * MiB, WS_LAM = 3 * MiB, WS_BP = 3 * MiB + 128 * 1024, WS_SST = 4 * MiB, WS_MEMN = 8 * MiB, WS_KVMEM = 10 * MiB,
                 WS_MK = 14 * MiB, WS_MV = 15 * MiB, WS_W = 16 * MiB, W_LAYER = 36 * MiB,
                 OFF_WIN = 0, OFF_WMKV = 10 * MiB, OFF_WGLU = 12 * MiB, OFF_WBR = 13 * MiB, OFF_WOUT = 16 * MiB, OFF_WUP = 18 * MiB, OFF_WDN = 29 * MiB + 512 * 1024,
                 WS_XN = 88 * MiB, WS_MERGED = 121 * MiB, WS_BR = 154 * MiB, WS_ZS = 204 * MiB, WS_Z = 221 * MiB, WS_H = WS_Z,
                 WS_LAMP = 378 * MiB, WS_BT1 = 380 * MiB, WS_BT2 = 396 * MiB, WS_A2 = 436 * MiB, WS_SS = 456 * MiB, WS_PART = 464 * MiB, WS_END = 486 * MiB;
static_assert(OFF_WDN + (size_t)1024 * 2816 * 2 <= W_LAYER, "weights");
static_assert(WS_Z + (size_t)MT * INW * 2 <= WS_LAMP, "Z");

constexpr int LDS_BYTES = 147456;
constexpr int NPS = 11;
constexpr int NPHASE = 1 + NPS * DEPTH;

struct Params { const float* in[32]; float* out; unsigned char* ws; int ph_lo, ph_hi; };

__device__ const double INVF[32] = {1.0,0.7498942093324559,0.5623413251903491,0.4216965034285822,0.31622776601683794,0.23713737056616552,0.1778279410038923,0.1333521432163324,0.1,0.07498942093324558,0.05623413251903491,0.042169650342858224,0.03162277660168379,0.023713737056616554,0.01778279410038923,0.01333521432163324,0.01,0.007498942093324558,0.005623413251903491,0.004216965034285823,0.0031622776601683794,0.0023713737056616554,0.0017782794100389228,0.001333521432163324,0.001,0.0007498942093324559,0.0005623413251903491,0.00042169650342858224,0.00031622776601683794,0.00023713737056616554,0.00017782794100389227,0.0001333521432163324};

__device__ __forceinline__ float bf2f(unsigned h) { return __uint_as_float(h << 16); }
__device__ __forceinline__ unsigned f2bf(float f) { unsigned u = __float_as_uint(f); return (u + 0x7fffu + ((u >> 16) & 1u)) >> 16; }
__device__ __forceinline__ unsigned pk2(float lo, float hi) { return f2bf(lo) | (f2bf(hi) << 16); }
typedef float f32x2_t __attribute__((ext_vector_type(2))); typedef __bf16 bf16x2_t __attribute__((ext_vector_type(2)));
__device__ __forceinline__ unsigned pk2h(float lo, float hi) { const f32x2_t v = {lo, hi}; const bf16x2_t b = __builtin_convertvector(v, bf16x2_t); return __builtin_bit_cast(unsigned, b); }
__device__ __forceinline__ float lo16(unsigned w) { return __uint_as_float(w << 16); }
__device__ __forceinline__ float hi16(unsigned w) { return __uint_as_float(w & 0xffff0000u); }
__device__ __forceinline__ float sigm(float x) { return __builtin_amdgcn_rcpf(1.0f + __builtin_amdgcn_exp2f(-1.4426950408889634f * x)); }
__device__ __forceinline__ float gelu_tanh(float y) { const float a = 0.7978845608028654f * (y + 0.044715f * y * y * y); const float th = 1.0f - 2.0f * __builtin_amdgcn_rcpf(__expf(2.0f * a) + 1.0f); return 0.5f * y * (1.0f + th); }
__device__ __forceinline__ float wave_sum(float v) {
#pragma unroll
    for (int o = 1; o < 64; o <<= 1) v += __shfl_xor(v, o);
    return v;
}
__device__ __forceinline__ void sincos_d(double x, double& s, double& c) {
    const double kd = rint(x * 0.63661977236758134308);
    double r = fma(-kd, 1.57079632679489655800e+00, x); r = fma(-kd, 6.12323399573676603587e-17, r);
    const int q = ((int)kd) & 3;
    const double r2 = r * r;
    const double sp = r * (1.0 + r2 * (-1.0 / 6.0 + r2 * (1.0 / 120.0 + r2 * (-1.0 / 5040.0 + r2 * (1.0 / 362880.0 + r2 * (-1.0 / 39916800.0 + r2 * (1.0 / 6227020800.0 + r2 * (-1.0 / 1307674368000.0 + r2 * (1.0 / 355687428096000.0)))))))));
    const double cp = 1.0 + r2 * (-0.5 + r2 * (1.0 / 24.0 + r2 * (-1.0 / 720.0 + r2 * (1.0 / 40320.0 + r2 * (-1.0 / 3628800.0 + r2 * (1.0 / 479001600.0 + r2 * (-1.0 / 87178291200.0 + r2 * (1.0 / 20922789888000.0))))))));
    s = (q == 0) ? sp : (q == 1) ? cp : (q == 2) ? -sp : -cp;
    c = (q == 0) ? cp : (q == 1) ? -sp : (q == 2) ? -cp : sp;
}

namespace pg8 {
#define PG8_LAS __attribute__((address_space(3)))
constexpr int BM = 256, BK = 64, HALF = 128, HTB = HALF * BK * 2, STAGE_BYTES = 8 * HTB, NXCD = 8, WGM = 4;
__host__ __device__ __forceinline__ int lds_byte(int r, int c) { const int st = (r >> 4) * 2 + (c >> 5), rr = r & 15, cc = c & 31, ob = rr * 64 + cc * 2; return st * 1024 + (ob ^ (((ob >> 9) & 1) << 5)); }
__host__ __device__ __forceinline__ void stage_rc(int b, int& R, int& C) { const int st = b / 1024, sb = b % 1024, swz = sb ^ (((sb >> 9) & 1) << 5); R = (st >> 1) * 16 + swz / 64; C = (st & 1) * 32 + (swz % 64) / 2; }
__host__ __device__ __forceinline__ int perm32(int rho) { const int n = rho >> 4, i = rho & 15; return 8 * (i >> 2) + 4 * n + (i & 3); }
struct Unit { int pm, pn, ko; };
struct Gemm { const bf16* A; const bf16* Bt; int M, N, K, lda, ldb; };
struct StaticOrder {
    int nM, nN, nwg, G, c;
    __host__ __device__ void init(int M, int N, int G_, int c_) { nM = M / BM; nN = N / BM; nwg = nM * nN; G = G_; c = c_; }
    __host__ __device__ bool next(int i, Unit& u) const {
        const long L = (long)i * G + c; if (L >= nwg) return false;
        int wgid = (int)L; { const int q = nwg / NXCD, r = nwg % NXCD, xcd = wgid % NXCD, off = wgid / NXCD; wgid = (xcd < r ? xcd * (q + 1) : r * (q + 1) + (xcd - r) * q) + off; }
        const int nig = WGM * nN, gid = wgid / nig, fm = gid * WGM, gsz = (nM - fm) < WGM ? (nM - fm) : WGM;
        u.pm = fm + ((wgid % nig) % gsz); u.pn = (wgid % nig) / gsz; u.ko = 0; return true;
    }
    __device__ __forceinline__ void a_ready(const Unit&) const {}
    __device__ __forceinline__ void done(const Unit&) const {}
};
struct GroupOrder {
    int G, c, nunits, mode;
    __device__ bool next(int i, Unit& u) const { int L = i * G + c; if (L >= nunits) return false;
        if (G == 256 && i == 0) { const int x = c & 7, y = c >> 3;
            L = (mode == 0) ? 2 * (x + 8 * (y >> 1)) + (y & 1) : 4 * (x + 8 * (y >> 2)) + (y & 3); }
        u.ko = 0; if (mode == 0) { u.pm = L; u.pn = L >> 1; } else { const int g = L >> 2; u.pm = 2 * g + ((L >> 1) & 1); u.pn = 2 * g + (L & 1); } return true; }
    __device__ __forceinline__ void a_ready(const Unit&) const {}
    __device__ __forceinline__ void done(const Unit&) const {}
};
struct RangeOrder {
    int G, c, pm0, nm, nn;
    __device__ bool next(int i, Unit& u) const { if (c < 0) return false; const int L = i * G + c; if (L >= nm * nn) return false; u.pm = pm0 + L / nn; u.pn = L % nn; u.ko = 0; return true; }
    __device__ __forceinline__ void a_ready(const Unit&) const {}
    __device__ __forceinline__ void done(const Unit&) const {}
};
struct TailOrder {
    int c, S, kslice_bytes, G;
    __device__ bool next(int i, Unit& u) const { const int L = i * G + c; if (c < 0 || L >= 8 * S) return false; const int un = L / S, ks = L - un * S; u.pm = 64 + (un >> 2); u.pn = un & 3; u.ko = ks * kslice_bytes; return true; }
    __device__ __forceinline__ void a_ready(const Unit&) const {}
    __device__ __forceinline__ void done(const Unit&) const {}
};
__device__ __forceinline__ u32x4 pack8(const f32x4 a, const f32x4 b) { u32x4 w; w.x = pk2h(a[0], a[1]); w.y = pk2h(a[2], a[3]); w.z = pk2h(b[0], b[1]); w.w = pk2h(b[2], b[3]); return w; }

struct EpiZ {
    static constexpr bool PERM = true, AFTER_DRAIN = false, HOOK = false;
    bf16* O; int ldc; int sig_from; bf16* A2;
    __device__ __forceinline__ void operator()(const f32x4 (&acc)[2][2][4][2], const Unit& u, int wr, int wc, int fr, int fq) const {
        const int row0 = u.pm * BM + wr * 64 + fr, col0 = u.pn * BM + wc * 32 + 8 * fq; const bool sg = u.pn >= sig_from;
#pragma unroll
        for (int ai = 0; ai < 2; ++ai)
#pragma unroll
            for (int m = 0; m < 4; ++m) { bf16* rowp = O + (size_t)(row0 + ai * HALF + m * 16) * ldc + col0;
#pragma unroll
                for (int bj = 0; bj < 2; ++bj) { f32x4 v0 = acc[ai][bj][m][0], v1 = acc[ai][bj][m][1];
                    if (sg) {
#pragma unroll
                        for (int e = 0; e < 4; ++e) { v0[e] = sigm(v0[e]); v1[e] = sigm(v1[e]); } }
                    const u32x4 pk = pack8(v0, v1); const bool utile = (u.pn == 3 || u.pn == 4) && u.pm < MP / BM;
                    if (!utile) *(u32x4*)(rowp + bj * HALF) = pk;
                    if (utile) { const int r = row0 + ai * HALF + m * 16, gg = (u.pn - 3) * 16 + bj * 8 + wc * 2 + (fq >> 1), t = r & (SEQ - 1);
                        *(u32x4*)(A2 + (size_t)(gg * 512 + (r >> 12) * 128 + (t >> 5)) * 640 + (t & 31) * 16 + (fq & 1) * 8) = pk; } } }
    }
};
struct EpiS {
    static constexpr bool PERM = false, AFTER_DRAIN = false, HOOK = false;
    float* SS;
    __device__ __forceinline__ void operator()(const f32x4 (&acc)[2][2][4][2], const Unit& u, int wr, int wc, int fr, int fq) const {
        const int row0 = u.pm * BM + wr * 64 + fr, col0 = wc * 32 + 4 * fq;
#pragma unroll
        for (int ai = 0; ai < 2; ++ai)
#pragma unroll
            for (int m = 0; m < 4; ++m) { float* rp = SS + (size_t)(row0 + ai * HALF + m * 16) * 128 + col0;
#pragma unroll
                for (int n = 0; n < 2; ++n) *(f32x4*)(rp + n * 16) = acc[ai][0][m][n]; }
    }
};
struct EpiY {
    static constexpr bool PERM = true, AFTER_DRAIN = false, HOOK = false;
    const bf16* A2; const float* Dv; bf16* ZS;
    __device__ __forceinline__ void operator()(const f32x4 (&acc)[2][2][4][2], const Unit& u, int wr, int wc, int fr, int fq) const {
        const int row0 = u.pm * BM + wr * 64 + fr, gg = u.pm >> 1, ct = u.pn & 1;
        const int cc0 = ct * 256 + wc * 32 + 8 * fq;
        const int c0 = cc0 & 15;
        const f32x4 d0 = *(const f32x4*)(Dv + gg * 16 + c0), d1 = *(const f32x4*)(Dv + gg * 16 + c0 + 4);
#pragma unroll
        for (int ai = 0; ai < 2; ++ai) { u32x4 uv[4][2];
#pragma unroll
            for (int m = 0; m < 4; ++m)
#pragma unroll
                for (int bj = 0; bj < 2; ++bj) uv[m][bj] = *(const u32x4*)(A2 + (size_t)(row0 + ai * HALF + m * 16) * 640 + ((cc0 + bj * HALF) >> 4) * 16 + c0);
            __builtin_amdgcn_sched_barrier(0);
#pragma unroll
            for (int m = 0; m < 4; ++m) { const int grow = row0 + ai * HALF + m * 16, bjr = grow & 511, b = bjr >> 7, j = bjr & 127;
#pragma unroll
                for (int bj = 0; bj < 2; ++bj) { const int t = (cc0 + bj * HALF) >> 4; const u32x4 uu = uv[m][bj];
                    const f32x4 a0 = acc[ai][bj][m][0], a1 = acc[ai][bj][m][1]; f32x4 v0, v1;
                    v0[0] = gelu_tanh(fmaf(d0[0], lo16(uu.x), a0[0])); v0[1] = gelu_tanh(fmaf(d0[1], hi16(uu.x), a0[1])); v0[2] = gelu_tanh(fmaf(d0[2], lo16(uu.y), a0[2])); v0[3] = gelu_tanh(fmaf(d0[3], hi16(uu.y), a0[3]));
                    v1[0] = gelu_tanh(fmaf(d1[0], lo16(uu.z), a1[0])); v1[1] = gelu_tanh(fmaf(d1[1], hi16(uu.z), a1[1])); v1[2] = gelu_tanh(fmaf(d1[2], lo16(uu.w), a1[2])); v1[3] = gelu_tanh(fmaf(d1[3], hi16(uu.w), a1[3]));
                    *(u32x4*)(ZS + (size_t)(b * SEQ + 32 * j + t) * 512 + gg * 16 + c0) = pack8(v0, v1); } }
            __builtin_amdgcn_sched_barrier(0); }
    }
};
struct EpiF32 {
    static constexpr bool PERM = false, AFTER_DRAIN = false, HOOK = false;
    float* O; int ldc;
    __device__ __forceinline__ void operator()(const f32x4 (&acc)[2][2][4][2], const Unit& u, int wr, int wc, int fr, int fq) const {
        const int row0 = u.pm * BM + wr * 64 + fr, col0 = u.pn * BM + wc * 32 + 4 * fq;
#pragma unroll
        for (int ai = 0; ai < 2; ++ai)
#pragma unroll
            for (int m = 0; m < 4; ++m) { float* rowp = O + (size_t)(row0 + ai * HALF + m * 16) * ldc + col0;
#pragma unroll
                for (int bj = 0; bj < 2; ++bj)
#pragma unroll
                    for (int n = 0; n < 2; ++n) *(f32x4*)(rowp + bj * HALF + n * 16) = acc[ai][bj][m][n]; }
    }
};
struct EpiRes {
    static constexpr bool PERM = false, AFTER_DRAIN = false, HOOK = false;
    const float* base_p; const float* base_s; float* out; int ldc;
    __device__ __forceinline__ void operator()(const f32x4 (&acc)[2][2][4][2], const Unit& u, int wr, int wc, int fr, int fq) const {
        const int row0 = u.pm * BM + wr * 64 + fr, col0 = u.pn * BM + wc * 32 + 4 * fq;
#pragma unroll
        for (int ai = 0; ai < 2; ++ai) { f32x4 bs[4][2][2];
#pragma unroll
            for (int m = 0; m < 4; ++m) { const int r = row0 + ai * HALF + m * 16; const float* bp = (r < MP) ? base_p + (size_t)r * ldc : base_s + (size_t)(r - MP) * ldc;
#pragma unroll
                for (int bj = 0; bj < 2; ++bj)
#pragma unroll
                    for (int n = 0; n < 2; ++n) bs[m][bj][n] = *(const f32x4*)(bp + col0 + bj * HALF + n * 16); }
            __builtin_amdgcn_sched_barrier(0);
#pragma unroll
            for (int m = 0; m < 4; ++m) { float* op = out + (size_t)(row0 + ai * HALF + m * 16) * ldc;
#pragma unroll
                for (int bj = 0; bj < 2; ++bj)
#pragma unroll
                    for (int n = 0; n < 2; ++n) *(f32x4*)(op + col0 + bj * HALF + n * 16) = bs[m][bj][n] + acc[ai][bj][m][n]; }
            __builtin_amdgcn_sched_barrier(0); }
    }
};
struct EpiGatePart {
    static constexpr bool PERM = false, AFTER_DRAIN = false, HOOK = false;
    const bf16* Z; float* part;
    __device__ __forceinline__ void operator()(const f32x4 (&acc)[2][2][4][2], const Unit& u, int wr, int wc, int fr, int fq) const {
        const int n = u.ko / 1024; const int row0 = u.pm * BM + wr * 64 + fr, col0 = u.pn * BM + wc * 32 + 4 * fq;
#pragma unroll
        for (int ai = 0; ai < 2; ++ai) { u32x2 gg[4][2][2];
#pragma unroll
            for (int m = 0; m < 4; ++m)
#pragma unroll
                for (int bj = 0; bj < 2; ++bj)
#pragma unroll
                    for (int nn = 0; nn < 2; ++nn) gg[m][bj][nn] = *(const u32x2*)(Z + (size_t)(row0 + ai * HALF + m * 16) * INW + GO + n * 1024 + col0 + bj * HALF + nn * 16);
            __builtin_amdgcn_sched_barrier(0);
#pragma unroll
            for (int m = 0; m < 4; ++m) { float* op = part + ((size_t)n * MS + (row0 - MP) + ai * HALF + m * 16) * DM + col0;
#pragma unroll
                for (int bj = 0; bj < 2; ++bj)
#pragma unroll
                    for (int nn = 0; nn < 2; ++nn) { const u32x2 g = gg[m][bj][nn]; const f32x4 a = acc[ai][bj][m][nn];
                        *(f32x4*)(op + bj * HALF + nn * 16) = (f32x4){a[0] * lo16(g.x), a[1] * hi16(g.x), a[2] * lo16(g.y), a[3] * hi16(g.y)}; } }
            __builtin_amdgcn_sched_barrier(0); }
    }
};
struct EpiPart {
    static constexpr bool PERM = false, AFTER_DRAIN = false, HOOK = false;
    float* part; int kslice_bytes;
    __device__ __forceinline__ void operator()(const f32x4 (&acc)[2][2][4][2], const Unit& u, int wr, int wc, int fr, int fq) const {
        const int ks = u.ko / kslice_bytes; const int row0 = (u.pm - 64) * BM + wr * 64 + fr, col0 = u.pn * BM + wc * 32 + 4 * fq;
#pragma unroll
        for (int ai = 0; ai < 2; ++ai)
#pragma unroll
            for (int m = 0; m < 4; ++m) { float* op = part + ((size_t)ks * MS + row0 + ai * HALF + m * 16) * DM + col0;
#pragma unroll
                for (int bj = 0; bj < 2; ++bj)
#pragma unroll
                    for (int n = 0; n < 2; ++n) *(f32x4*)(op + bj * HALF + n * 16) = acc[ai][bj][m][n]; }
    }
};
struct EpiGlu {
    static constexpr bool PERM = true, AFTER_DRAIN = false, HOOK = false;
    const bf16* ZS; bf16* BR;
    __device__ __forceinline__ void operator()(const f32x4 (&acc)[2][2][4][2], const Unit& u, int wr, int wc, int fr, int fq) const {
        const int row0 = u.pm * BM + wr * 64 + fr, col0 = u.pn * BM + wc * 32 + 8 * fq;
#pragma unroll
        for (int ai = 0; ai < 2; ++ai) { u32x4 zz[4][2];
#pragma unroll
            for (int m = 0; m < 4; ++m)
#pragma unroll
                for (int bj = 0; bj < 2; ++bj) zz[m][bj] = *(const u32x4*)(ZS + (size_t)(row0 + ai * HALF + m * 16) * 512 + col0 + bj * HALF);
            __builtin_amdgcn_sched_barrier(0);
#pragma unroll
            for (int m = 0; m < 4; ++m) { const int r = row0 + ai * HALF + m * 16;
#pragma unroll
                for (int bj = 0; bj < 2; ++bj) { const int c = col0 + bj * HALF; const u32x4 z = zz[m][bj];
                    const f32x4 a0 = acc[ai][bj][m][0], a1 = acc[ai][bj][m][1]; f32x4 v0, v1;
                    v0[0] = lo16(z.x) * sigm(a0[0]); v0[1] = hi16(z.x) * sigm(a0[1]); v0[2] = lo16(z.y) * sigm(a0[2]); v0[3] = hi16(z.y) * sigm(a0[3]);
                    v1[0] = lo16(z.z) * sigm(a1[0]); v1[1] = hi16(z.z) * sigm(a1[1]); v1[2] = lo16(z.w) * sigm(a1[2]); v1[3] = hi16(z.w) * sigm(a1[3]);
                    *(u32x4*)(BR + (size_t)r * 1536 + 512 + c) = pack8(v0, v1); } }
            __builtin_amdgcn_sched_barrier(0); }
    }
};
struct EpiSwiglu {
    static constexpr bool PERM = true, AFTER_DRAIN = false, HOOK = false;
    bf16* H;
    __device__ __forceinline__ void operator()(const f32x4 (&acc)[2][2][4][2], const Unit& u, int wr, int wc, int fr, int fq) const {
        const int row0 = u.pm * BM + wr * 64 + fr, col0 = u.pn * HALF + wc * 32 + 8 * fq;
#pragma unroll
        for (int ai = 0; ai < 2; ++ai)
#pragma unroll
            for (int m = 0; m < 4; ++m) { const int r = row0 + ai * HALF + m * 16; f32x4 v0, v1;
#pragma unroll
                for (int e = 0; e < 4; ++e) { const float g0 = acc[ai][0][m][0][e], g1 = acc[ai][0][m][1][e]; v0[e] = g0 * sigm(g0) * acc[ai][1][m][0][e]; v1[e] = g1 * sigm(g1) * acc[ai][1][m][1][e]; }
                *(u32x4*)(H + (size_t)r * DFF + col0) = pack8(v0, v1); }
    }
};
struct EpiMerge {
    static constexpr bool PERM = true, AFTER_DRAIN = false, HOOK = true;
    const bf16* Z; bf16* O;
    __device__ __forceinline__ void hook(f32x4 (&acc)[2][2][4][2], const Unit& u, int t, int wr, int wc, int fr, int fq) const {
        const int n = (t >> 3) - 1; int frx = fr, fqx = fq; asm volatile("" : "+v"(frx), "+v"(fqx)); const int row0 = u.pm * BM + wr * 64 + frx, col0 = u.pn * BM + wc * 32 + 8 * fqx;
#pragma unroll
        for (int ai = 0; ai < 2; ++ai) { u32x4 ga[4][2], gb[4][2];
#pragma unroll
            for (int m = 0; m < 4; ++m) { const bf16* zr = Z + (size_t)(row0 + ai * HALF + m * 16) * INW + GO + n * 1024 + col0;
#pragma unroll
                for (int bj = 0; bj < 2; ++bj) { ga[m][bj] = *(const u32x4*)(zr + bj * HALF); gb[m][bj] = *(const u32x4*)(zr + 1024 + bj * HALF); } }
            __builtin_amdgcn_sched_barrier(0);
#pragma unroll
            for (int m = 0; m < 4; ++m)
#pragma unroll
                for (int bj = 0; bj < 2; ++bj) { const unsigned aw[4] = {ga[m][bj].x, ga[m][bj].y, ga[m][bj].z, ga[m][bj].w}, bw[4] = {gb[m][bj].x, gb[m][bj].y, gb[m][bj].z, gb[m][bj].w};
#pragma unroll
                    for (int e = 0; e < 4; ++e) { const float r0 = lo16(aw[e]) * __builtin_amdgcn_rcpf(fmaxf(lo16(bw[e]), 1e-20f)), r1 = hi16(aw[e]) * __builtin_amdgcn_rcpf(fmaxf(hi16(bw[e]), 1e-20f));
                        acc[ai][bj][m][e >> 1][(e & 1) * 2] *= r0; acc[ai][bj][m][e >> 1][(e & 1) * 2 + 1] *= r1; } }
            __builtin_amdgcn_sched_barrier(0); }
    }
    __device__ __forceinline__ void operator()(const f32x4 (&acc)[2][2][4][2], const Unit& u, int wr, int wc, int fr, int fq) const {
        const int row0 = u.pm * BM + wr * 64 + fr, col0 = u.pn * BM + wc * 32 + 8 * fq;
#pragma unroll
        for (int ai = 0; ai < 2; ++ai) { u32x4 gg[4][2];
#pragma unroll
            for (int m = 0; m < 4; ++m)
#pragma unroll
                for (int bj = 0; bj < 2; ++bj) gg[m][bj] = *(const u32x4*)(Z + (size_t)(row0 + ai * HALF + m * 16) * INW + GO + 2048 + col0 + bj * HALF);
            __builtin_amdgcn_sched_barrier(0);
#pragma unroll
            for (int m = 0; m < 4; ++m) { const int r = row0 + ai * HALF + m * 16;
#pragma unroll
                for (int bj = 0; bj < 2; ++bj) { const unsigned gw[4] = {gg[m][bj].x, gg[m][bj].y, gg[m][bj].z, gg[m][bj].w}; f32x4 v0, v1;
#pragma unroll
                    for (int e = 0; e < 2; ++e) { v0[2 * e] = acc[ai][bj][m][0][2 * e] * fmaxf(lo16(gw[e]), 1e-20f); v0[2 * e + 1] = acc[ai][bj][m][0][2 * e + 1] * fmaxf(hi16(gw[e]), 1e-20f);
                        v1[2 * e] = acc[ai][bj][m][1][2 * e] * fmaxf(lo16(gw[2 + e]), 1e-20f); v1[2 * e + 1] = acc[ai][bj][m][1][2 * e + 1] * fmaxf(hi16(gw[2 + e]), 1e-20f); }
                    *(u32x4*)(O + (size_t)r * DM + col0 + bj * HALF) = pack8(v0, v1); } }
            __builtin_amdgcn_sched_barrier(0); }
    }
};

template <class Epi, class Sched, bool ALIGN_EPI = false, bool SP2 = false>
__device__ __forceinline__ void gemm_phase(PG8_LAS unsigned char* lds, const Gemm g, const Sched& S, const Epi& E) {
    const int tid = threadIdx.x, wid = __builtin_amdgcn_readfirstlane(tid >> 6), lane = tid & 63, wr = wid >> 2, wc = wid & 3, fr = lane & 15, fq = lane >> 4;
    const int K = g.K, nt = K / BK, lda = g.lda, ldb = g.ldb;
    unsigned voffA[2], voffB[2];
#pragma unroll
    for (int i = 0; i < 2; ++i) { int R, C; stage_rc(tid * 16 + i * 8192, R, C); const int Rb = Epi::PERM ? ((R & ~31) + perm32(R & 31)) : R;
        voffA[i] = (unsigned)(R * lda + C) * 2u; voffB[i] = (unsigned)(Rb * ldb + C) * 2u; }
    const size_t kstep = (size_t)(BK * 2);
    const size_t hstep = (size_t)HALF * ldb * 2;
    const size_t tstep = 2 * hstep;
    const size_t hstepA = (size_t)HALF * lda * 2, tstepA = 2 * hstepA;
    const unsigned ldsw = (unsigned)wid * 1024u;
    const int aoff = lds_byte(wr * 64 + fr, fq * 8), boff = lds_byte(wc * 32 + fr, fq * 8);
#define PG8_SA(b, h) (((b) * 2 + (h)) * HTB)
#define PG8_SB(b, h) ((4 + (b) * 2 + (h)) * HTB)
#define PG8_STAGE(bufoff, gbase, voff) do { _Pragma("unroll") for (int _i = 0; _i < 2; ++_i) \
        __builtin_amdgcn_global_load_lds((const unsigned*)((const char*)(gbase) + (voff)[_i]), (PG8_LAS unsigned*)(lds + (bufoff) + ldsw + _i * 8192), 16, 0, 0); } while (0)
#define PG8_LDA(dst, b, h) do { _Pragma("unroll") for (int m = 0; m < 4; ++m) _Pragma("unroll") for (int k = 0; k < 2; ++k) dst[m][k] = *(const PG8_LAS bf16x8*)(lds + PG8_SA(b, h) + aoff + m * 2048 + k * 1024); } while (0)
#define PG8_LDB(dst, b, h) do { _Pragma("unroll") for (int n = 0; n < 2; ++n) _Pragma("unroll") for (int k = 0; k < 2; ++k) dst[n][k] = *(const PG8_LAS bf16x8*)(lds + PG8_SB(b, h) + boff + n * 2048 + k * 1024); } while (0)
#define PG8_MMA(ai, bj, At, Bt) do { __builtin_amdgcn_s_setprio(1); _Pragma("unroll") for (int m = 0; m < 4; ++m) _Pragma("unroll") for (int n = 0; n < 2; ++n) _Pragma("unroll") for (int k = 0; k < 2; ++k) \
        acc[ai][bj][m][n] = __builtin_amdgcn_mfma_f32_16x16x32_bf16(Bt[n][k], At[m][k], acc[ai][bj][m][n], 0, 0, 0); __builtin_amdgcn_s_setprio(0); } while (0)
#define PG8_WAIT_V(n) asm volatile("s_waitcnt vmcnt(" #n ")" ::: "memory")
#define PG8_WAIT_L(n) asm volatile("s_waitcnt lgkmcnt(" #n ")" ::: "memory")
#define PG8_BAR __builtin_amdgcn_s_barrier()
#define PG8_SCHED __builtin_amdgcn_sched_barrier(0)
    Unit cur, nxt; int ui = 0;
    if (!S.next(0, cur)) return;
    f32x4 acc[2][2][4][2];
#pragma unroll
    for (int a = 0; a < 2; ++a)
#pragma unroll
        for (int b = 0; b < 2; ++b)
#pragma unroll
            for (int m = 0; m < 4; ++m)
#pragma unroll
                for (int n = 0; n < 2; ++n) acc[a][b][m][n] = (f32x4){0.f, 0.f, 0.f, 0.f};
    bf16x8 At[4][2], B0[2][2], B1[2][2];
    const char* cA = (const char*)g.A + (size_t)cur.pm * tstepA + cur.ko; const char* cB = (const char*)g.Bt + (size_t)cur.pn * tstep + cur.ko;
    S.a_ready(cur);
    if constexpr (SP2) {
        PG8_STAGE(PG8_SB(0, 0), cB, voffB); PG8_STAGE(PG8_SB(0, 1), cB + hstep, voffB); PG8_STAGE(PG8_SA(0, 0), cA, voffA); PG8_STAGE(PG8_SA(0, 1), cA + hstepA, voffA);
        if (wr == 1) PG8_BAR;
        PG8_WAIT_V(2); PG8_BAR;
        PG8_STAGE(PG8_SB(1, 0), cB + kstep, voffB); PG8_STAGE(PG8_SA(1, 0), cA + kstep, voffA); PG8_STAGE(PG8_SB(1, 1), cB + hstep + kstep, voffB);
        PG8_WAIT_V(6); PG8_BAR;
    } else {
        PG8_STAGE(PG8_SB(0, 0), cB, voffB); PG8_STAGE(PG8_SA(0, 0), cA, voffA); PG8_STAGE(PG8_SB(0, 1), cB + hstep, voffB); PG8_STAGE(PG8_SA(0, 1), cA + hstepA, voffA);
        if (wr == 1) PG8_BAR;
        PG8_WAIT_V(4); PG8_BAR;
        PG8_STAGE(PG8_SB(1, 0), cB + kstep, voffB); PG8_STAGE(PG8_SA(1, 0), cA + kstep, voffA); PG8_STAGE(PG8_SB(1, 1), cB + hstep + kstep, voffB);
        PG8_WAIT_V(6); PG8_BAR;
    }
    for (;;) {
        const bool has_next = S.next(ui + 1, nxt);
        const char* nA = has_next ? (const char*)g.A + (size_t)nxt.pm * tstepA + nxt.ko : cA; const char* nB = has_next ? (const char*)g.Bt + (size_t)nxt.pn * tstep + nxt.ko : cB;
        for (int t = 0; t < nt; t += 2) {
            const bool last = (t == nt - 2);
            const char* a1 = cA + (size_t)(t + 1) * kstep;
            const char* a2 = last ? nA : cA + (size_t)(t + 2) * kstep; const char* b2 = last ? nB : cB + (size_t)(t + 2) * kstep;
            const char* a3 = a2 + kstep; const char* b3 = b2 + kstep;
            if (last && has_next) S.a_ready(nxt);
            if constexpr (Epi::HOOK) { if (t == 8 || t == 16) E.hook(acc, cur, t, wr, wc, fr, fq); }
            if constexpr (SP2) {
            PG8_LDB(B0, 0, 0); PG8_LDB(B1, 0, 1); PG8_SCHED; PG8_LDA(At, 0, 0); PG8_STAGE(PG8_SA(1, 1), a1 + hstepA, voffA);
            PG8_WAIT_V(8); PG8_WAIT_L(0); PG8_BAR; PG8_MMA(0, 0, At, B0); PG8_MMA(0, 1, At, B1); PG8_BAR; PG8_SCHED;
            PG8_LDA(At, 0, 1); PG8_STAGE(PG8_SB(0, 0), b2, voffB); PG8_STAGE(PG8_SB(0, 1), b2 + hstep, voffB); PG8_STAGE(PG8_SA(0, 0), a2, voffA);
            PG8_WAIT_V(8); PG8_WAIT_L(0); PG8_BAR; PG8_MMA(1, 0, At, B0); PG8_MMA(1, 1, At, B1); PG8_BAR; PG8_SCHED;
            PG8_LDB(B0, 1, 0); PG8_LDB(B1, 1, 1); PG8_SCHED; PG8_LDA(At, 1, 0); PG8_STAGE(PG8_SA(0, 1), a2 + hstepA, voffA);
            PG8_WAIT_V(8); PG8_WAIT_L(0); PG8_BAR; PG8_MMA(0, 0, At, B0); PG8_MMA(0, 1, At, B1); PG8_BAR; PG8_SCHED;
            PG8_LDA(At, 1, 1); PG8_STAGE(PG8_SB(1, 0), b3, voffB); PG8_STAGE(PG8_SB(1, 1), b3 + hstep, voffB); PG8_STAGE(PG8_SA(1, 0), a3, voffA);
            PG8_WAIT_V(8); PG8_WAIT_L(0); PG8_BAR; PG8_MMA(1, 0, At, B0); PG8_MMA(1, 1, At, B1); PG8_BAR; PG8_SCHED;
            } else {
            PG8_LDB(B0, 0, 0); PG8_SCHED; PG8_LDA(At, 0, 0); PG8_STAGE(PG8_SA(1, 1), a1 + hstepA, voffA);
            PG8_WAIT_L(8); PG8_BAR; PG8_WAIT_L(0); PG8_MMA(0, 0, At, B0); PG8_BAR; PG8_SCHED;
            PG8_LDB(B1, 0, 1); PG8_STAGE(PG8_SB(0, 0), b2, voffB);
            PG8_BAR; PG8_WAIT_L(0); PG8_MMA(0, 1, At, B1); PG8_BAR;
            PG8_LDA(At, 0, 1); PG8_STAGE(PG8_SA(0, 0), a2, voffA);
            PG8_BAR; PG8_WAIT_L(0); PG8_MMA(1, 0, At, B0); PG8_BAR; PG8_SCHED;
            PG8_STAGE(PG8_SB(0, 1), b2 + hstep, voffB);
            PG8_WAIT_V(6); PG8_BAR; PG8_MMA(1, 1, At, B1); PG8_BAR;
            PG8_LDB(B0, 1, 0); PG8_SCHED; PG8_LDA(At, 1, 0); PG8_STAGE(PG8_SA(0, 1), a2 + hstepA, voffA);
            PG8_WAIT_L(8); PG8_BAR; PG8_WAIT_L(0); PG8_MMA(0, 0, At, B0); PG8_BAR; PG8_SCHED;
            PG8_LDB(B1, 1, 1); PG8_STAGE(PG8_SB(1, 0), b3, voffB);
            PG8_BAR; PG8_WAIT_L(0); PG8_MMA(0, 1, At, B1); PG8_BAR;
            PG8_LDA(At, 1, 1); PG8_STAGE(PG8_SA(1, 0), a3, voffA);
            PG8_BAR; PG8_WAIT_L(0); PG8_MMA(1, 0, At, B0); PG8_BAR; PG8_SCHED;
            PG8_STAGE(PG8_SB(1, 1), b3 + hstep, voffB);
            PG8_WAIT_V(6); PG8_BAR; PG8_MMA(1, 1, At, B1); PG8_BAR;
            }
        }
        if constexpr (ALIGN_EPI) { if (wr == 0) PG8_BAR; }
        if constexpr (!Epi::AFTER_DRAIN) { E(acc, cur, wr, wc, fr, fq); S.done(cur); }
        if (!has_next) break;
#pragma unroll
        for (int a = 0; a < 2; ++a)
#pragma unroll
            for (int b = 0; b < 2; ++b)
#pragma unroll
                for (int m = 0; m < 4; ++m)
#pragma unroll
                    for (int n = 0; n < 2; ++n) acc[a][b][m][n] = (f32x4){0.f, 0.f, 0.f, 0.f};
        cur = nxt; cA = nA; cB = nB; ++ui;
        if constexpr (ALIGN_EPI) { if (wr == 1) PG8_BAR; }
    }
    PG8_WAIT_V(0);
    if constexpr (!ALIGN_EPI) { if (wr == 0) PG8_BAR; }
    PG8_BAR;
#undef PG8_SA
#undef PG8_SB
#undef PG8_STAGE
#undef PG8_LDA
#undef PG8_LDB
#undef PG8_MMA
#undef PG8_WAIT_V
#undef PG8_WAIT_L
#undef PG8_BAR
#undef PG8_SCHED
}
}

__device__ __forceinline__ void transpose_item(const float* W, int N, bf16* WT, int ldt, int koff, const float* gain, int upperm, LAS float* scr, int kb, int nb, int lane) {
    const int k0 = 64 * kb, n0 = 64 * nb;
    f32x4 v[16]; float gv[16];
#pragma unroll
    for (int i = 0; i < 16; ++i) { const int kk = 4 * i + (lane >> 4); v[i] = *(const f32x4*)(W + (size_t)(k0 + kk) * N + n0 + (lane & 15) * 4); gv[i] = gain ? gain[k0 + kk] : 1.0f; }
    __builtin_amdgcn_sched_barrier(0);
#pragma unroll
    for (int i = 0; i < 16; ++i) { const int kk = 4 * i + (lane >> 4); const float gg = gv[i]; LAS float* s = scr + kk * 65 + (lane & 15) * 4;
        s[0] = v[i].x * gg; s[1] = v[i].y * gg; s[2] = v[i].z * gg; s[3] = v[i].w * gg; }
    asm volatile("s_waitcnt lgkmcnt(0)" ::: "memory");
    const int c = lane & 7;
#pragma unroll
    for (int j = 0; j < 8; ++j) { const int n = (lane >> 3) + 8 * j; const LAS float* s = scr + (8 * c) * 65 + n;
        u32x4 o; o.x = pk2h(s[0 * 65], s[1 * 65]); o.y = pk2h(s[2 * 65], s[3 * 65]); o.z = pk2h(s[4 * 65], s[5 * 65]); o.w = pk2h(s[6 * 65], s[7 * 65]);
        int dr = n0 + n; if (upperm) { dr = (dr < DFF) ? (dr >> 7) * 256 + (dr & 127) : ((dr - DFF) >> 7) * 256 + 128 + ((dr - DFF) & 127); }
        *(u32x4*)(WT + (size_t)dr * ldt + koff + k0 + 8 * c) = o; }
    asm volatile("s_waitcnt lgkmcnt(0)" ::: "memory");
}
constexpr int TI_WIN = 16 * 76, TI_MKV = 16 * 16, TI_GLU = 8 * 8, TI_BR = 8 * 16, TI_OUT = 16 * 16, TI_UP = 16 * 88, TI_DN = 44 * 16;
constexpr int TI_LAYER = TI_WIN + TI_MKV + TI_GLU + 3 * TI_BR + TI_OUT + TI_UP + TI_DN;
__device__ __forceinline__ void weight_item(const Params& P, int it, LAS float* scr, int lane) {
    const int l = it / TI_LAYER; int r = it % TI_LAYER;
    unsigned char* wb = P.ws + WS_W + (size_t)l * W_LAYER;
    const float* W; int N; bf16* WT; int ldt, koff = 0, up = 0; const float* gain = nullptr;
    if (r < TI_WIN) { W = P.in[10] + (size_t)l * DM * INW; N = INW; WT = (bf16*)(wb + OFF_WIN); ldt = DM; gain = P.in[9] + l * DM; }
    else if ((r -= TI_WIN) < TI_MKV) { W = P.in[24] + (size_t)l * DM * 1024; N = 1024; WT = (bf16*)(wb + OFF_WMKV); ldt = DM; gain = P.in[23] + l * DM; }
    else if ((r -= TI_MKV) < TI_GLU) { W = P.in[22] + (size_t)l * 512 * 512; N = 512; WT = (bf16*)(wb + OFF_WGLU); ldt = 512; }
    else if ((r -= TI_GLU) < 3 * TI_BR) { const int nbr = r / TI_BR; r -= nbr * TI_BR; W = P.in[27] + ((size_t)l * 3 + nbr) * 512 * DM; N = DM; WT = (bf16*)(wb + OFF_WBR); ldt = 1536; koff = nbr * 512; }
    else if ((r -= 3 * TI_BR) < TI_OUT) { W = P.in[28] + (size_t)l * DM * DM; N = DM; WT = (bf16*)(wb + OFF_WOUT); ldt = DM; }
    else if ((r -= TI_OUT) < TI_UP) { W = P.in[30] + (size_t)l * DM * 2 * DFF; N = 2 * DFF; WT = (bf16*)(wb + OFF_WUP); ldt = DM; gain = P.in[29] + l * DM; up = 1; }
    else { r -= TI_UP; W = P.in[31] + (size_t)l * DFF * DM; N = DM; WT = (bf16*)(wb + OFF_WDN); ldt = DFF; }
    const int nblk = N / 64;
    transpose_item(W, N, WT, ldt, koff, gain, up, scr, r / nblk, r % nblk, lane);
}
__device__ __forceinline__ void rms_row_to_bf16(const float* xrow, bf16* orow, int lane, const float* part = nullptr, int npart = 0, float* xout = nullptr, bool want_xn = true) {
    const f32x4* xr = (const f32x4*)xrow + lane;
    f32x4 v[4]; float s = 0.f;
#pragma unroll
    for (int j = 0; j < 4; ++j) v[j] = xr[64 * j];
    if (part) { for (int k = 0; k < npart; ++k) { const f32x4* pr = (const f32x4*)(part + (size_t)k * MS * DM) + lane;
#pragma unroll
            for (int j = 0; j < 4; ++j) v[j] += pr[64 * j]; }
#pragma unroll
        for (int j = 0; j < 4; ++j) ((f32x4*)xout + lane)[64 * j] = v[j]; }
    if (!want_xn) return;
#pragma unroll
    for (int j = 0; j < 4; ++j) s += (v[j].x * v[j].x + v[j].y * v[j].y) + (v[j].z * v[j].z + v[j].w * v[j].w);
    const float rstd = 1.0f / sqrtf(wave_sum(s) * (1.f / DM) + EPS);
    u32x2* o8 = (u32x2*)orow + lane;
#pragma unroll
    for (int j = 0; j < 4; ++j) { u32x2 w; w.x = pk2(v[j].x * rstd, v[j].y * rstd); w.y = pk2(v[j].z * rstd, v[j].w * rstd); o8[64 * j] = w; }
}

template <bool OUT, int NPRE = 0>
__device__ __forceinline__ void ssm_run(const bf16* Zu, int L, float lr, float li, const float (&br)[16], const float (&bi)[16], float& hr, float& hi,
                                        const float (&cr)[16], const float (&ci)[16], float dcl, bf16* zs_out, int lane) {
    const int cl = lane >> 2;
    u32x4 pu0[NPRE > 0 ? NPRE : 1], pu1[NPRE > 0 ? NPRE : 1]; unsigned short pcl[NPRE > 0 ? NPRE : 1];
    if constexpr (NPRE > 0) {
#pragma unroll
        for (int t = 0; t < NPRE; ++t) { const bf16* up = Zu + (size_t)t * INW; pu0[t] = *(const u32x4*)up; pu1[t] = *(const u32x4*)(up + 8); pcl[t] = up[cl]; }
        __builtin_amdgcn_sched_barrier(0);
    }
#pragma unroll
    for (int t = 0; t < (NPRE > 0 ? NPRE : L); ++t) {
        const bf16* up = Zu + (size_t)t * INW;
        u32x4 u0, u1; if constexpr (NPRE > 0) { u0 = pu0[t]; u1 = pu1[t]; } else { u0 = *(const u32x4*)up; u1 = *(const u32x4*)(up + 8); }
        float u[16];
        u[0] = lo16(u0.x); u[1] = hi16(u0.x); u[2] = lo16(u0.y); u[3] = hi16(u0.y); u[4] = lo16(u0.z); u[5] = hi16(u0.z); u[6] = lo16(u0.w); u[7] = hi16(u0.w);
        u[8] = lo16(u1.x); u[9] = hi16(u1.x); u[10] = lo16(u1.y); u[11] = hi16(u1.y); u[12] = lo16(u1.z); u[13] = hi16(u1.z); u[14] = lo16(u1.w); u[15] = hi16(u1.w);
        float bur = 0.f, bui = 0.f;
#pragma unroll
        for (int c = 0; c < 16; ++c) { bur = fmaf(br[c], u[c], bur); bui = fmaf(bi[c], u[c], bui); }
        const float nr = fmaf(lr, hr, fmaf(-li, hi, bur)), ni = fmaf(lr, hi, fmaf(li, hr, bui));
        hr = nr; hi = ni;
        if constexpr (OUT) {
            float v[16];
#pragma unroll
            for (int c = 0; c < 16; ++c) v[c] = fmaf(cr[c], nr, -ci[c] * ni);
            float w8[8], w4[4], w2[2];
            { const bool h = lane & 32;
#pragma unroll
              for (int i = 0; i < 8; ++i) { const float send = h ? v[i] : v[i + 8], keep = h ? v[i + 8] : v[i]; w8[i] = keep + __shfl_xor(send, 32); } }
            { const bool h = lane & 16;
#pragma unroll
              for (int i = 0; i < 4; ++i) { const float send = h ? w8[i] : w8[i + 4], keep = h ? w8[i + 4] : w8[i]; w4[i] = keep + __shfl_xor(send, 16); } }
            { const bool h = lane & 8;
#pragma unroll
              for (int i = 0; i < 2; ++i) { const float send = h ? w4[i] : w4[i + 2], keep = h ? w4[i + 2] : w4[i]; w2[i] = keep + __shfl_xor(send, 8); } }
            float y;
            { const bool h = lane & 4; const float send = h ? w2[0] : w2[1], keep = h ? w2[1] : w2[0]; y = keep + __shfl_xor(send, 4); }
            y += __shfl_xor(y, 1); y += __shfl_xor(y, 2);
            const float ucl = bf2f(NPRE > 0 ? pcl[t] : up[cl]);
            y = fmaf(dcl, ucl, y);
            const float a = 0.7978845608028654f * (y + 0.044715f * y * y * y);
            const float th = 1.0f - 2.0f * __builtin_amdgcn_rcpf(__expf(2.0f * a) + 1.0f);
            const float z = 0.5f * y * (1.0f + th);
            if ((lane & 3) == 0) zs_out[(size_t)t * 512] = (bf16)f2bf(z);
        }
    }
}

__device__ __forceinline__ bf16x8 ld_q8(const bf16* p) { return *(const bf16x8*)p; }
template <int MODE>
__device__ __forceinline__ void swa_qtile(const LAS bf16* Ksm, const LAS bf16* Vt, int kt0, const bf16* qptr, float sink, int iq, int jmin, bf16* optr, int lane) {
    constexpr int NKT = 10, KST = 72, VST = 264;
    const int lq = lane & 15, lg = lane >> 4;
    bf16x8 qf[2];
#pragma unroll
    for (int kk = 0; kk < 2; ++kk) qf[kk] = ld_q8(qptr + 32 * kk + 8 * lg);
    f32x4 s[NKT];
#pragma unroll
    for (int kt = 0; kt < NKT; ++kt) { s[kt] = (f32x4){0.f, 0.f, 0.f, 0.f};
#pragma unroll
        for (int kk = 0; kk < 2; ++kk) { const bf16x8 kf = *(const LAS bf16x8*)(Ksm + (16 * (kt0 + kt) + lq) * KST + 32 * kk + 8 * lg); s[kt] = __builtin_amdgcn_mfma_f32_16x16x32_bf16(kf, qf[kk], s[kt], 0, 0, 0); } }
    float mx = -INFINITY;
#pragma unroll
    for (int kt = 0; kt < NKT; ++kt)
#pragma unroll
        for (int e = 0; e < 4; ++e) { const int j = 16 * (kt0 + kt) + 4 * lg + e; bool ok;
            if (MODE == 0) ok = (j > iq) && (j <= iq + 128) && (j >= jmin);
            else { const int t = lq >> 2; ok = (j < 128) ? (j >= t + 1) : (j < 132 && (j - 128) <= t); }
            const float v = ok ? s[kt][e] * 0.125f : -INFINITY; s[kt][e] = v; mx = fmaxf(mx, v); }
    mx = fmaxf(mx, __shfl_xor(mx, 16)); mx = fmaxf(mx, __shfl_xor(mx, 32)); mx = fmaxf(mx, sink);
    float sum = 0.f;
#pragma unroll
    for (int kt = 0; kt < NKT; ++kt)
#pragma unroll
        for (int e = 0; e < 4; ++e) { const float p = __expf(s[kt][e] - mx); s[kt][e] = p; sum += p; }
    sum += __shfl_xor(sum, 16); sum += __shfl_xor(sum, 32);
    const float inv = 1.0f / (sum + __expf(sink - mx));
    f32x4 o[4];
#pragma unroll
    for (int dt = 0; dt < 4; ++dt) o[dt] = (f32x4){0.f, 0.f, 0.f, 0.f};
#pragma unroll
    for (int st = 0; st < NKT / 2; ++st) {
        u32x4 pw; pw.x = pk2(s[2 * st][0] * inv, s[2 * st][1] * inv); pw.y = pk2(s[2 * st][2] * inv, s[2 * st][3] * inv); pw.z = pk2(s[2 * st + 1][0] * inv, s[2 * st + 1][1] * inv); pw.w = pk2(s[2 * st + 1][2] * inv, s[2 * st + 1][3] * inv);
        const bf16x8 pf = __builtin_bit_cast(bf16x8, pw);
#pragma unroll
        for (int dt = 0; dt < 4; ++dt) { const LAS bf16* vp = Vt + (16 * dt + lq) * VST + 16 * (kt0 + 2 * st) + 4 * lg;
            const s16x4 lo = *(const LAS s16x4*)vp, hi = *(const LAS s16x4*)(vp + 16);
            const bf16x8 vf = __builtin_shufflevector(lo, hi, 0, 1, 2, 3, 4, 5, 6, 7);
            o[dt] = __builtin_amdgcn_mfma_f32_16x16x32_bf16(vf, pf, o[dt], 0, 0, 0); } }
#pragma unroll
    for (int dt = 0; dt < 4; ++dt) { u32x2 w; w.x = pk2(o[dt][0], o[dt][1]); w.y = pk2(o[dt][2], o[dt][3]); *(u32x2*)(optr + 16 * dt + 4 * lg) = w; }
}
__device__ __forceinline__ void mem_qtile(const LAS bf16* Ksm, const LAS bf16* Vt, const bf16* qptr, bf16* optr, bool store_ok, int lane) {
    constexpr int KST = 136, VST = 264;
    const int lq = lane & 15, lg = lane >> 4;
    bf16x8 qf[4];
#pragma unroll
    for (int kk = 0; kk < 4; ++kk) qf[kk] = ld_q8(qptr + 32 * kk + 8 * lg);
    f32x4 s[16];
#pragma unroll
    for (int kt = 0; kt < 16; ++kt) { s[kt] = (f32x4){0.f, 0.f, 0.f, 0.f};
#pragma unroll
        for (int kk = 0; kk < 4; ++kk) { const bf16x8 kf = *(const LAS bf16x8*)(Ksm + (16 * kt + lq) * KST + 32 * kk + 8 * lg); s[kt] = __builtin_amdgcn_mfma_f32_16x16x32_bf16(kf, qf[kk], s[kt], 0, 0, 0); } }
    float mx = -INFINITY;
#pragma unroll
    for (int kt = 0; kt < 16; ++kt)
#pragma unroll
        for (int e = 0; e < 4; ++e) { const float v = s[kt][e] * 0.08838834764831845f; s[kt][e] = v; mx = fmaxf(mx, v); }
    mx = fmaxf(mx, __shfl_xor(mx, 16)); mx = fmaxf(mx, __shfl_xor(mx, 32));
    float sum = 0.f;
#pragma unroll
    for (int kt = 0; kt < 16; ++kt)
#pragma unroll
        for (int e = 0; e < 4; ++e) { const float p = __expf(s[kt][e] - mx); s[kt][e] = p; sum += p; }
    sum += __shfl_xor(sum, 16); sum += __shfl_xor(sum, 32);
    const float inv = 1.0f / sum;
    int xs[4], ys[4]; { const int x0 = (4 * lg) ^ ((lq >> 3) << 2);
#pragma unroll
        for (int c = 0; c < 4; ++c) { xs[c] = x0 ^ (8 * c); ys[c] = xs[c] ^ 16; } }
    f32x4 o[8];
#pragma unroll
    for (int dt = 0; dt < 8; ++dt) o[dt] = (f32x4){0.f, 0.f, 0.f, 0.f};
#pragma unroll
    for (int st = 0; st < 8; ++st) {
        u32x4 pw; pw.x = pk2(s[2 * st][0] * inv, s[2 * st][1] * inv); pw.y = pk2(s[2 * st][2] * inv, s[2 * st][3] * inv); pw.z = pk2(s[2 * st + 1][0] * inv, s[2 * st + 1][1] * inv); pw.w = pk2(s[2 * st + 1][2] * inv, s[2 * st + 1][3] * inv);
        const bf16x8 pf = __builtin_bit_cast(bf16x8, pw);
#pragma unroll
        for (int dt = 0; dt < 8; ++dt) { constexpr int dummy = 0; const int cdt = (8 * dt) & 63, hi5 = (32 * st) ^ (cdt & 32), cs = (cdt >> 3) & 3; const LAS bf16* vr = Vt + (16 * dt + lq) * VST + hi5;
            const s16x4 lo = *(const LAS s16x4*)(vr + xs[cs]), hi = *(const LAS s16x4*)(vr + ys[cs]);
            const bf16x8 vf = __builtin_shufflevector(lo, hi, 0, 1, 2, 3, 4, 5, 6, 7);
            o[dt] = __builtin_amdgcn_mfma_f32_16x16x32_bf16(vf, pf, o[dt], 0, 0, 0); } }
    if (store_ok) {
#pragma unroll
        for (int dt = 0; dt < 8; ++dt) { u32x2 w; w.x = pk2(o[dt][0], o[dt][1]); w.y = pk2(o[dt][2], o[dt][3]); *(u32x2*)(optr + 16 * dt + 4 * lg) = w; }
    }
}
template <bool SWZ>
__device__ __forceinline__ void vt_scatter(LAS bf16* Vt, int vst, int d0, int key, const u32x4 v) {
    const unsigned w[4] = {v.x, v.y, v.z, v.w};
    const int kc = SWZ ? (key ^ (((d0 >> 3) & 15) << 2)) : key;
#pragma unroll
    for (int e = 0; e < 4; ++e) { Vt[(d0 + 2 * e) * vst + kc] = (bf16)(w[e] & 0xffffu); Vt[(d0 + 2 * e + 1) * vst + kc] = (bf16)(w[e] >> 16); }
}
__device__ __forceinline__ u32x4 cvt8(const float* p) { const f32x4 a = *(const f32x4*)p, b = *(const f32x4*)(p + 4); u32x4 w; w.x = pk2(a.x, a.y); w.y = pk2(a.z, a.w); w.z = pk2(b.x, b.y); w.w = pk2(b.z, b.w); return w; }

__device__ __forceinline__ void mem_prompt_item(int i2, const bf16* Z, const bf16* MK, const bf16* MV, bf16* BR, LAS unsigned char* lds, int tid, int wave, int lane) {
    const int qc = i2 & 15, hm = (i2 >> 4) & 3, b = i2 >> 6;
    LAS bf16* Ksm = (LAS bf16*)lds; LAS bf16* Vt = (LAS bf16*)(lds + 256 * 136 * 2);
    { u32x4 kq[8], vq[8];
#pragma unroll
    for (int i = 0; i < 8; ++i) { const int cid = tid + 512 * i, key = cid >> 4, ch = cid & 15; const size_t so = (size_t)(b * NMEM + key) * 512 + hm * 128 + ch * 8; kq[i] = *(const u32x4*)(MK + so); vq[i] = *(const u32x4*)(MV + so); }
    __builtin_amdgcn_sched_barrier(0);
#pragma unroll
    for (int i = 0; i < 8; ++i) { const int cid = tid + 512 * i, key = cid >> 4, ch = cid & 15; *(LAS u32x4*)(Ksm + key * 136 + ch * 8) = kq[i]; vt_scatter<true>(Vt, 264, ch * 8, key, vq[i]); }
    __builtin_amdgcn_sched_barrier(0); }
    __syncthreads();
#pragma unroll 1
    for (int qt = 0; qt < 2; ++qt) { asm volatile("" ::: "memory"); const size_t row = (size_t)b * SEQ + qc * 256 + wave * 32 + qt * 16 + (lane & 15);
        mem_qtile(Ksm, Vt, Z + row * INW + MQO + hm * 128, BR + row * 1536 + 1024 + hm * 128, true, lane); }
    __syncthreads();
}
constexpr int MEMP_S2 = 28, MEMP_S3 = 124, MEMP_S4 = 104;
static_assert(MEMP_S2 + MEMP_S3 + MEMP_S4 == 256, "mem prompt items");

struct PRow { u32x4 qv, kvv, mv; f32x4 r0, r1, r2, r3; };
__device__ __forceinline__ PRow post_load(const bf16* Z, const float* ROPE, int r, int lane) {
    PRow p; const bf16* zr = Z + (size_t)r * INW; const int pidx = (r < MP) ? (r & (SEQ - 1)) : SEQ + ((r - MP) & 3);
    p.qv = *(const u32x4*)(zr + lane * 8); p.kvv = *(const u32x4*)(zr + KO + (lane & 31) * 8); p.mv = *(const u32x4*)(zr + MQO + lane * 8);
    const f32x4* rp = (const f32x4*)(ROPE + (size_t)(pidx * 32 + (lane & 3) * 8) * 2); p.r0 = rp[0]; p.r1 = rp[1]; p.r2 = rp[2]; p.r3 = rp[3];
    return p;
}

template <int ph, bool DRY = false>
__device__ __forceinline__ void run_phase(const Params& P, LAS unsigned char* lds) {
    const int tid = threadIdx.x, lane = tid & 63, wave = __builtin_amdgcn_readfirstlane(tid >> 6);
    const int G = gridDim.x, bid = blockIdx.x;
    const int gw = bid * 8 + wave, NGW = G * 8;
    const int gt = bid * 512 + tid, NGT = G * 512;
    unsigned char* ws = P.ws;
    float* out = P.out;
    bf16* XN = (bf16*)(ws + WS_XN); bf16* Z = (bf16*)(ws + WS_Z); bf16* BR = (bf16*)(ws + WS_BR); bf16* ZS = (bf16*)(ws + WS_ZS);
    bf16* MERGED = (bf16*)(ws + WS_MERGED); bf16* HB = (bf16*)(ws + WS_H); bf16* MEMN = (bf16*)(ws + WS_MEMN); float* KVMEM = (float*)(ws + WS_KVMEM);
    bf16* MK = (bf16*)(ws + WS_MK); bf16* MV = (bf16*)(ws + WS_MV); float* ROPE = (float*)(ws + WS_ROPE);
    float* X = out;

    {
        if constexpr (ph == 0) { if (PHM & 2048) {
            for (int pass = 0; pass < 2; ++pass) {
            if ((pass == 0) == ((bid & 1) != 0)) {
                LAS float* Cre = (LAS float*)lds; LAS float* Cim = Cre + 1024; LAS float* Bsm = Cre + 2048; LAS float* Lsm = Cre + 4096; LAS float* Msm = Cre + 8448;
                for (int it = bid; it < 256; it += G) {
                    const int lg = it >> 2, q = it & 3;
                    for (int e = tid; e < 1024; e += 512) { Cre[e] = P.in[19][(size_t)lg * 1024 + e]; Cim[e] = P.in[20][(size_t)lg * 1024 + e]; }
                    if (tid < 64) { const int p = tid, e = lg * 64 + p;
                        const double are = (double)P.in[14][e], aim = (double)P.in[15][e], dt = exp((double)P.in[16][lg]);
                        const double mag = exp(are * dt); double sn, cs; sincos_d(aim * dt, sn, cs);
                        const double lre = mag * cs, lim = mag * sn, den = are * are + aim * aim, nr = lre - 1.0, ni = lim;
                        const double gre = (nr * are + ni * aim) / den, gim = (ni * are - nr * aim) / den;
                        double qr = 1.0, qi = 0.0;
                        for (int qq = 0; qq <= 32; ++qq) { Lsm[(qq * 64 + p) * 2] = (float)qr; Lsm[(qq * 64 + p) * 2 + 1] = (float)qi; const double a = qr * lre - qi * lim, b = qr * lim + qi * lre; qr = a; qi = b; }
                        const float* bre = P.in[17] + (size_t)e * 16; const float* bim = P.in[18] + (size_t)e * 16;
                        for (int c = 0; c < 16; ++c) { const double br = bre[c], bi = bim[c]; Bsm[p * 32 + c] = (float)(gre * br - gim * bi); Bsm[p * 32 + 16 + c] = (float)(gre * bi + gim * br); } }
                    __syncthreads();
                    { const int tau = tid >> 4, cb = (tid >> 2) & 3, c2b = tid & 3; float o[4][4];
#pragma unroll
                      for (int i = 0; i < 4; ++i)
#pragma unroll
                          for (int jx = 0; jx < 4; ++jx) o[i][jx] = 0.f;
                      for (int p = 0; p < 64; ++p) { const float lr = Lsm[(tau * 64 + p) * 2], li = Lsm[(tau * 64 + p) * 2 + 1]; float clr[4], cli[4];
#pragma unroll
                          for (int i = 0; i < 4; ++i) { const float cr = Cre[(4 * cb + i) * 64 + p], ci = Cim[(4 * cb + i) * 64 + p]; clr[i] = cr * lr - ci * li; cli[i] = cr * li + ci * lr; }
#pragma unroll
                          for (int jx = 0; jx < 4; ++jx) { const float br = Bsm[p * 32 + 4 * c2b + jx], bi = Bsm[p * 32 + 16 + 4 * c2b + jx];
#pragma unroll
                              for (int i = 0; i < 4; ++i) o[i][jx] += clr[i] * br - cli[i] * bi; } }
#pragma unroll
                      for (int i = 0; i < 4; ++i)
#pragma unroll
                          for (int jx = 0; jx < 4; ++jx) Msm[(tau * 16 + 4 * cb + i) * 16 + 4 * c2b + jx] = o[i][jx]; }
                    __syncthreads();
                    bf16* bt2 = (bf16*)(ws + WS_BT2) + (size_t)lg * 512 * 640; bf16* bt1 = (bf16*)(ws + WS_BT1) + (size_t)lg * 256 * 512;
                    for (int k = 0; k < 16; ++k) { const int id = tid + 512 * k, rl = id >> 6, cc = id & 63, t = 8 * q + (rl >> 4), c = rl & 15, sp = cc >> 1, c0 = (cc & 1) * 8;
                        u32x4 w = (u32x4){0u, 0u, 0u, 0u};
                        if (sp <= t) { const LAS float* mp = Msm + ((t - sp) * 16 + c) * 16 + c0; w.x = pk2(mp[0], mp[1]); w.y = pk2(mp[2], mp[3]); w.z = pk2(mp[4], mp[5]); w.w = pk2(mp[6], mp[7]); }
                        *(u32x4*)(bt2 + (size_t)(t * 16 + c) * 640 + sp * 16 + c0) = w; }
                    for (int k = 0; k < 4; ++k) { const int id = tid + 512 * k, rl = id >> 4, cc = id & 15, t = 8 * q + (rl >> 4), c = rl & 15, isim = cc >> 3, p0 = (cc & 7) * 8; float v[8];
#pragma unroll
                        for (int e = 0; e < 8; ++e) { const int p = p0 + e; const float lr = Lsm[((t + 1) * 64 + p) * 2], li = Lsm[((t + 1) * 64 + p) * 2 + 1], cr = Cre[c * 64 + p], ci = Cim[c * 64 + p];
                            v[e] = isim ? -(cr * li + ci * lr) : (cr * lr - ci * li); }
                        u32x4 w; w.x = pk2(v[0], v[1]); w.y = pk2(v[2], v[3]); w.z = pk2(v[4], v[5]); w.w = pk2(v[6], v[7]);
                        *(u32x4*)(bt2 + (size_t)(t * 16 + c) * 640 + 512 + isim * 64 + p0) = w; }
                    for (int k = 0; k < 4; ++k) { const int id = tid + 512 * k, rl = id >> 6, cc = id & 63, sp = cc >> 1, c0 = (cc & 1) * 8, isim = q >> 1, p = (q & 1) * 32 + rl; float v[8];
                        const float lr = Lsm[((31 - sp) * 64 + p) * 2], li = Lsm[((31 - sp) * 64 + p) * 2 + 1];
#pragma unroll
                        for (int e = 0; e < 8; ++e) { const float br = Bsm[p * 32 + c0 + e], bi = Bsm[p * 32 + 16 + c0 + e]; v[e] = isim ? (lr * bi + li * br) : (lr * br - li * bi); }
                        u32x4 w; w.x = pk2(v[0], v[1]); w.y = pk2(v[2], v[3]); w.z = pk2(v[4], v[5]); w.w = pk2(v[6], v[7]);
                        *(u32x4*)(bt1 + (size_t)(isim * 64 + p) * 512 + sp * 16 + c0) = w; }
                    __syncthreads();
                }
            } else {
            LAS float* scr = (LAS float*)(lds + wave * 16640);
            for (int it = gw; it < DEPTH * TI_LAYER; it += NGW) weight_item(P, it, scr, lane);
            for (int m = gw; m < MEMROWS; m += NGW) rms_row_to_bf16(P.in[8] + (size_t)m * DM, MEMN + (size_t)m * DM, lane);
            for (int m = gw; m < MT; m += NGW) rms_row_to_bf16(m < MP ? P.in[0] + (size_t)m * DM : P.in[1] + (size_t)(m - MP) * DM, XN + (size_t)m * DM, lane);
            for (int e = gt; e < MS * DM / 4; e += NGT) ((f32x4*)(X + (size_t)MP * DM))[e] = ((const f32x4*)P.in[1])[e];
            for (int e = gt; e < NPOS * 32; e += NGT) { const int pi = e >> 5, i = e & 31; const double pos = (pi < SEQ) ? (double)pi : (double)(PAST + pi - SEQ);
                double sn, cs; sincos_d(pos * INVF[i], sn, cs); ROPE[2 * e] = (float)cs; ROPE[2 * e + 1] = (float)sn; }
            for (int e = gt; e < DEPTH * 32 * 64; e += NGT) { const int l = e >> 11, g = (e >> 6) & 31, p = e & 63;
                const double are = (double)P.in[14][e], aim = (double)P.in[15][e], dt = exp((double)P.in[16][l * 32 + g]);
                const double mag = exp(are * dt); double sn, cs; sincos_d(aim * dt, sn, cs);
                const double lre = mag * cs, lim = mag * sn, den = are * are + aim * aim, nr = lre - 1.0, ni = lim;
                const double gre = (nr * are + ni * aim) / den, gim = (ni * are - nr * aim) / den;
                double pr = lre, pi2 = lim;
                { float* lp = (float*)(ws + WS_LAMP) + ((size_t)(l * 32 + g) * 33 * 64 + p) * 2; double qr = 1.0, qi = 0.0;
                  for (int q = 0; q <= 32; ++q) { lp[(size_t)q * 128] = (float)qr; lp[(size_t)q * 128 + 1] = (float)qi; const double a = qr * lre - qi * lim, b = qr * lim + qi * lre; qr = a; qi = b; } }
#pragma unroll
                for (int q = 0; q < 5; ++q) { const double a = pr * pr - pi2 * pi2, b = 2.0 * pr * pi2; pr = a; pi2 = b; }
                float* lam = (float*)(ws + WS_LAM) + (size_t)e * 4; lam[0] = (float)lre; lam[1] = (float)lim; lam[2] = (float)pr; lam[3] = (float)pi2;
                float* bp = (float*)(ws + WS_BP) + (size_t)e * 32; const f32x4* bre = (const f32x4*)(P.in[17] + (size_t)e * 16); const f32x4* bim = (const f32x4*)(P.in[18] + (size_t)e * 16);
                const f32x4 r0 = bre[0], r1 = bre[1], r2 = bre[2], r3 = bre[3], i0 = bim[0], i1 = bim[1], i2 = bim[2], i3 = bim[3];
                __builtin_amdgcn_sched_barrier(0);
                const float brv[16] = {r0.x, r0.y, r0.z, r0.w, r1.x, r1.y, r1.z, r1.w, r2.x, r2.y, r2.z, r2.w, r3.x, r3.y, r3.z, r3.w}, biv[16] = {i0.x, i0.y, i0.z, i0.w, i1.x, i1.y, i1.z, i1.w, i2.x, i2.y, i2.z, i2.w, i3.x, i3.y, i3.z, i3.w};
#pragma unroll
                for (int c = 0; c < 16; ++c) { const double br = brv[c], bi = biv[c]; bp[c] = (float)(gre * br - gim * bi); bp[16 + c] = (float)(gre * bi + gim * br); } }
            }
            __syncthreads();
            }
            }
            return;
        }
        constexpr int l = (ph == 0) ? 0 : (ph - 1) / NPS, s = (ph == 0) ? -1 : (ph - 1) % NPS;
        const int off128 = (G == 256) ? 128 : 0;
        bf16* A2 = (bf16*)(ws + WS_A2); float* SS = (float*)(ws + WS_SS); const float* LAMP = (const float*)(ws + WS_LAMP);
        unsigned char* wb = ws + WS_W + (size_t)l * W_LAYER;
        if constexpr (s == 0 && (PHM & 1)) {
            { pg8::Gemm g{XN, (const bf16*)(wb + OFF_WIN), MT, INW, DM, DM, DM}; pg8::StaticOrder S; S.init(MT, INW, G, bid);
              pg8::EpiZ E{Z, INW, GO / 256, A2}; pg8::gemm_phase<pg8::EpiZ, pg8::StaticOrder, true, true>(lds, g, S, E); }
            { pg8::Gemm g{MEMN, (const bf16*)(wb + OFF_WMKV), MEMROWS, 1024, DM, DM, DM}; pg8::StaticOrder S; S.init(MEMROWS, 1024, G, G - 1 - bid);
              pg8::EpiF32 E{KVMEM, 1024}; pg8::gemm_phase<pg8::EpiF32, pg8::StaticOrder, true, true>(lds, g, S, E); }
        } else if constexpr (s == 1 && (PHM & 2)) {
            { pg8::Gemm g{A2, (const bf16*)(ws + WS_BT1) + (size_t)l * 32 * 256 * 512, 16384, 8192, 512, 640, 512}; pg8::GroupOrder S{G, bid, 64, 0};
              pg8::EpiS E{SS}; pg8::gemm_phase<pg8::EpiS, pg8::GroupOrder, true, true>(lds, g, S, E); }
            const float* qn = P.in[11] + l * 64; const float* kn = P.in[12] + l * 64; const float* mqn = P.in[25] + l * 128; const float* mkn = P.in[26] + l * 128;
            const bool bal = (G == 256); const int R1 = bal ? 4 * NGW : MT, gw2 = gw - 512, NGW2 = NGW - 512;
            const f32x4 gq0 = *(const f32x4*)(qn + (lane & 7) * 8), gq1 = *(const f32x4*)(qn + (lane & 7) * 8 + 4);
            const f32x4 gk0 = *(const f32x4*)(kn + (lane & 7) * 8), gk1 = *(const f32x4*)(kn + (lane & 7) * 8 + 4);
            const f32x4 gm0 = *(const f32x4*)(mqn + (lane & 15) * 8), gm1 = *(const f32x4*)(mqn + (lane & 15) * 8 + 4);
            int rr = gw, part2 = 0;
#define NEXT_ROW(dst) do { dst = -1; if (!part2 && rr >= R1) { if (bal && bid >= 64) { part2 = 1; rr = R1 + gw2; } else rr = MT; } if (rr < MT) { dst = rr; rr += part2 ? NGW2 : NGW; } } while (0)
            int rcur; NEXT_ROW(rcur);
            PRow cur; if (rcur >= 0) cur = post_load(Z, ROPE, rcur, lane);
            while (rcur >= 0) {
                int rnext; NEXT_ROW(rnext);
                PRow nxt = cur; if (rnext >= 0) nxt = post_load(Z, ROPE, rnext, lane);
                __builtin_amdgcn_sched_barrier(0);
                const int r = rcur;
                bf16* zr = Z + (size_t)r * INW; bf16* zw = DRY ? BR + (size_t)r * 1536 : zr;
                int ob; float* okp; float* ovp; bool wr_out;
                if (r < MP) { const int t = r & (SEQ - 1), b = r >> 12; wr_out = t >= SEQ - 128; ob = ((l * NB + b) * 128 + (t - (SEQ - 128))) * 128; okp = out + O_KP; ovp = out + O_VP; }
                else { const int rs = r - MP, b = rs >> 2, t = rs & 3; wr_out = true; ob = ((l * DBATCH + b) * 128 + 124 + t) * 128; okp = out + O_KS; ovp = out + O_VS; }
                const u32x4 qv = cur.qv, kvv = cur.kvv, mv = cur.mv; const f32x4 r0 = cur.r0, r1 = cur.r1, r2 = cur.r2, r3 = cur.r3;
                const float cs[8] = {r0.x, r0.z, r1.x, r1.z, r2.x, r2.z, r3.x, r3.z}, sn[8] = {r0.y, r0.w, r1.y, r1.w, r2.y, r2.w, r3.y, r3.w};
                const float gq[8] = {gq0.x, gq0.y, gq0.z, gq0.w, gq1.x, gq1.y, gq1.z, gq1.w}, gk[8] = {gk0.x, gk0.y, gk0.z, gk0.w, gk1.x, gk1.y, gk1.z, gk1.w}, gm[8] = {gm0.x, gm0.y, gm0.z, gm0.w, gm1.x, gm1.y, gm1.z, gm1.w};
                const bool hi_half = (lane & 4) != 0;
                {
                    float x[8] = {lo16(qv.x), hi16(qv.x), lo16(qv.y), hi16(qv.y), lo16(qv.z), hi16(qv.z), lo16(qv.w), hi16(qv.w)}; float ss = 0.f;
#pragma unroll
                    for (int j = 0; j < 8; ++j) ss = fmaf(x[j], x[j], ss);
                    ss += __shfl_xor(ss, 1); ss += __shfl_xor(ss, 2); ss += __shfl_xor(ss, 4);
                    const float rs = 1.0f / sqrtf(ss * (1.f / 64.f) + EPS); float o[8];
#pragma unroll
                    for (int j = 0; j < 8; ++j) { const float vn = x[j] * rs * gq[j]; const float pt = __shfl_xor(vn, 4); o[j] = hi_half ? vn * cs[j] + pt * sn[j] : vn * cs[j] - pt * sn[j]; }
                    u32x4 w; w.x = pk2(o[0], o[1]); w.y = pk2(o[2], o[3]); w.z = pk2(o[4], o[5]); w.w = pk2(o[6], o[7]); *(u32x4*)(zw + lane * 8) = w; }
                {
                    float x[8] = {lo16(kvv.x), hi16(kvv.x), lo16(kvv.y), hi16(kvv.y), lo16(kvv.z), hi16(kvv.z), lo16(kvv.w), hi16(kvv.w)}; float ss = 0.f;
#pragma unroll
                    for (int j = 0; j < 8; ++j) ss = fmaf(x[j], x[j], ss);
                    ss += __shfl_xor(ss, 1); ss += __shfl_xor(ss, 2); ss += __shfl_xor(ss, 4);
                    const float rs = 1.0f / sqrtf(ss * (1.f / 64.f) + EPS); float o[8];
#pragma unroll
                    for (int j = 0; j < 8; ++j) { const float vn = x[j] * rs * gk[j]; const float pt = __shfl_xor(vn, 4); o[j] = hi_half ? vn * cs[j] + pt * sn[j] : vn * cs[j] - pt * sn[j]; }
                    if (lane < 16) { u32x4 w; w.x = pk2(o[0], o[1]); w.y = pk2(o[2], o[3]); w.z = pk2(o[4], o[5]); w.w = pk2(o[6], o[7]); *(u32x4*)(zw + KO + lane * 8) = w;
                        if (wr_out) { *(f32x4*)(okp + (size_t)ob + lane * 8) = (f32x4){o[0], o[1], o[2], o[3]}; *(f32x4*)(okp + (size_t)ob + lane * 8 + 4) = (f32x4){o[4], o[5], o[6], o[7]}; } }
                    else if (lane < 32 && wr_out) { *(f32x4*)(ovp + (size_t)ob + (lane - 16) * 8) = (f32x4){x[0], x[1], x[2], x[3]}; *(f32x4*)(ovp + (size_t)ob + (lane - 16) * 8 + 4) = (f32x4){x[4], x[5], x[6], x[7]}; } }
                {
                    float x[8] = {lo16(mv.x), hi16(mv.x), lo16(mv.y), hi16(mv.y), lo16(mv.z), hi16(mv.z), lo16(mv.w), hi16(mv.w)}; float ss = 0.f;
#pragma unroll
                    for (int j = 0; j < 8; ++j) ss = fmaf(x[j], x[j], ss);
                    ss += __shfl_xor(ss, 1); ss += __shfl_xor(ss, 2); ss += __shfl_xor(ss, 4); ss += __shfl_xor(ss, 8);
                    const float rs = 1.0f / sqrtf(ss * (1.f / 128.f) + EPS);
                    u32x4 w; w.x = pk2(x[0] * rs * gm[0], x[1] * rs * gm[1]); w.y = pk2(x[2] * rs * gm[2], x[3] * rs * gm[3]); w.z = pk2(x[4] * rs * gm[4], x[5] * rs * gm[5]); w.w = pk2(x[6] * rs * gm[6], x[7] * rs * gm[7]);
                    *(u32x4*)(zw + (DRY ? 640 : MQO) + lane * 8) = w; }
                cur = nxt; rcur = rnext;
            }
#undef NEXT_ROW
            for (int mr = (bal ? (bid >= 64 ? gw - 512 : MEMROWS) : gw); mr < MEMROWS; mr += (bal ? NGW - 512 : NGW)) {
                const float* src = KVMEM + (size_t)mr * 1024; float* ok = out + O_MKP + ((size_t)l * MEMROWS + mr) * 512; float* ov = out + O_MVP + ((size_t)l * MEMROWS + mr) * 512;
                float kx[8], vx[8];
#pragma unroll
                for (int i = 0; i < 8; ++i) { kx[i] = src[i * 64 + lane]; vx[i] = src[512 + i * 64 + lane]; }
                __builtin_amdgcn_sched_barrier(0);
#pragma unroll
                for (int hm = 0; hm < 4; ++hm) { const float a = kx[2 * hm], b2 = kx[2 * hm + 1];
                    const float ss = wave_sum(a * a + b2 * b2); const float rs = 1.0f / sqrtf(ss * (1.f / 128.f) + EPS);
                    const float ka = a * rs * mkn[lane], kb = b2 * rs * mkn[64 + lane];
                    ok[hm * 128 + lane] = ka; ok[hm * 128 + 64 + lane] = kb; MK[(size_t)mr * 512 + hm * 128 + lane] = (bf16)f2bf(ka); MK[(size_t)mr * 512 + hm * 128 + 64 + lane] = (bf16)f2bf(kb); }
#pragma unroll
                for (int i = 0; i < 8; ++i) { ov[i * 64 + lane] = vx[i]; MV[(size_t)mr * 512 + i * 64 + lane] = (bf16)f2bf(vx[i]); }
            }
            { const f32x4* ck = (const f32x4*)(P.in[2] + (size_t)l * DBATCH * 128 * 128); const f32x4* cv = (const f32x4*)(P.in[3] + (size_t)l * DBATCH * 128 * 128);
              f32x4* dk = (f32x4*)(out + O_KS + (size_t)l * DBATCH * 128 * 128); f32x4* dv = (f32x4*)(out + O_VS + (size_t)l * DBATCH * 128 * 128);
              for (int e = gt; e < DBATCH * 124 * 32; e += 2 * NGT) { const int e2 = e + NGT; const bool ok2 = e2 < DBATCH * 124 * 32; const int b = e / (124 * 32), rem = e % (124 * 32), b2 = ok2 ? e2 / (124 * 32) : b, rem2 = ok2 ? e2 % (124 * 32) : rem;
                  const f32x4 k0 = ck[b * 4096 + 128 + rem], v0 = cv[b * 4096 + 128 + rem], k1 = ck[b2 * 4096 + 128 + rem2], v1 = cv[b2 * 4096 + 128 + rem2];
                  __builtin_amdgcn_sched_barrier(0);
                  dk[b * 4096 + rem] = k0; dv[b * 4096 + rem] = v0; if (ok2) { dk[b2 * 4096 + rem2] = k1; dv[b2 * 4096 + rem2] = v1; } } }
        } else if constexpr (s == 2 && (PHM & 4)) {
            const bool balI = (G == 256); int nsamp = 0, js0 = 0, js1 = 0, js2 = 0;
            if (balI) { if (bid < 16) { nsamp = 1; js0 = 240 + bid; } else if (bid < 60) { nsamp = 3; js0 = bid - 16; js1 = 240 + bid; js2 = (bid < 44) ? 196 + bid : 452 + bid; }
                        else if (bid < 228) { nsamp = 2; js0 = bid - 16; js1 = 240 + bid; } else { nsamp = 1; js0 = 240 + bid; } }
            const int nk_main = ((balI ? 1296 : 1296 + 512) - 1 - bid) / G + 1, nk_items = nk_main + nsamp;
            for (int kk = 0; kk < nk_items; ++kk) { const int slot = (bid & 1) ? (nk_items - 1 - kk) : kk; int it;
                if (slot < nk_main) it = bid + slot * G; else { const int q = slot - nk_main; it = 1296 + (q == 0 ? js0 : (q == 1 ? js1 : js2)); }
              for (int rep = 0; rep < ((it < 1280) ? REP_ATT : REP_SSM2); ++rep) { asm volatile("" ::: "memory");
                if (it < 256) { if (ITM & 1) {
                    const int kvh = it & 1, blk = (it >> 1) & 31, b = it >> 6;
                    LAS bf16* Ksm = (LAS bf16*)lds; LAS bf16* Vt = (LAS bf16*)(lds + 256 * 72 * 2);
                    { u32x4 kq[4], vq[4];
#pragma unroll
                    for (int i = 0; i < 4; ++i) { const int cid = tid + 512 * i, key = cid >> 3, ch = cid & 7; const int trow = (blk - 1) * 128 + key;
                        kq[i] = (u32x4){0u, 0u, 0u, 0u}; vq[i] = kq[i];
                        if (trow >= 0) { const bf16* zr = Z + (size_t)(b * SEQ + trow) * INW; kq[i] = *(const u32x4*)(zr + KO + kvh * 64 + ch * 8); vq[i] = *(const u32x4*)(zr + VO + kvh * 64 + ch * 8); } }
                    __builtin_amdgcn_sched_barrier(0);
#pragma unroll
                    for (int i = 0; i < 4; ++i) { const int cid = tid + 512 * i, key = cid >> 3, ch = cid & 7;
                        *(LAS u32x4*)(Ksm + key * 72 + ch * 8) = kq[i]; vt_scatter<false>(Vt, 264, ch * 8, key, vq[i]); }
                    __builtin_amdgcn_sched_barrier(0); }
                    __syncthreads();
                    const int gq = wave >> 1, qh = wave & 1, hq = kvh * 4 + gq; const float sink = P.in[13][l * 8 + hq];
#pragma unroll 1
                    for (int qt = 0; qt < 4; ++qt) { asm volatile("" ::: "memory"); const int i0 = qh * 64 + qt * 16; const size_t row = (size_t)b * SEQ + blk * 128 + i0 + (lane & 15);
                        swa_qtile<0>(Ksm, Vt, (i0 >> 4) < 6 ? (i0 >> 4) : 6, Z + row * INW + hq * 64, sink, i0 + (lane & 15), blk > 0 ? 0 : 128, BR + row * 1536 + hq * 64, lane); }
                    __syncthreads();
                } } else if (it < 512) { if (ITM & 2) {
                    const int i2 = it - 256, kvh = i2 & 1, b = i2 >> 1;
                    LAS bf16* Ksm = (LAS bf16*)lds; LAS bf16* Vt = (LAS bf16*)(lds + 256 * 72 * 2);
                    { f32x4 kf[3][2], vf[3][2]; u32x4 kz[3], vz[3];
#pragma unroll
                    for (int i = 0; i < 3; ++i) { const int cid = tid + 512 * i, key = cid >> 3, ch = cid & 7;
                        kf[i][0] = kf[i][1] = vf[i][0] = vf[i][1] = (f32x4){0.f, 0.f, 0.f, 0.f}; kz[i] = vz[i] = (u32x4){0u, 0u, 0u, 0u};
                        if (key < 128) { const size_t so = ((((size_t)l * DBATCH + b) * 128 + key) * 2 + kvh) * 64 + ch * 8;
                            kf[i][0] = *(const f32x4*)(P.in[2] + so); kf[i][1] = *(const f32x4*)(P.in[2] + so + 4); vf[i][0] = *(const f32x4*)(P.in[3] + so); vf[i][1] = *(const f32x4*)(P.in[3] + so + 4); }
                        else if (key < 132) { const bf16* zr = Z + (size_t)(MP + b * 4 + key - 128) * INW; kz[i] = *(const u32x4*)(zr + KO + kvh * 64 + ch * 8); vz[i] = *(const u32x4*)(zr + VO + kvh * 64 + ch * 8); } }
                    __builtin_amdgcn_sched_barrier(0);
#pragma unroll
                    for (int i = 0; i < 3; ++i) { const int cid = tid + 512 * i; if (cid < 1280) { const int key = cid >> 3, ch = cid & 7;
                        u32x4 kv = kz[i], vv = vz[i];
                        if (key < 128) { kv.x = pk2(kf[i][0].x, kf[i][0].y); kv.y = pk2(kf[i][0].z, kf[i][0].w); kv.z = pk2(kf[i][1].x, kf[i][1].y); kv.w = pk2(kf[i][1].z, kf[i][1].w);
                            vv.x = pk2(vf[i][0].x, vf[i][0].y); vv.y = pk2(vf[i][0].z, vf[i][0].w); vv.z = pk2(vf[i][1].x, vf[i][1].y); vv.w = pk2(vf[i][1].z, vf[i][1].w); }
                        *(LAS u32x4*)(Ksm + key * 72 + ch * 8) = kv; vt_scatter<false>(Vt, 264, ch * 8, key, vv); } }
                    __builtin_amdgcn_sched_barrier(0); }
                    __syncthreads();
                    if (wave == 0) { const int lq = lane & 15, t = lq >> 2, gq = lq & 3, hq = kvh * 4 + gq; const size_t row = (size_t)MP + b * 4 + t;
                        swa_qtile<1>(Ksm, Vt, 0, Z + row * INW + hq * 64, P.in[13][l * 8 + hq], 0, 0, BR + row * 1536 + hq * 64, lane); }
                    __syncthreads();
                } } else if (it < 768) { if (ITM & 4) {
                    if (it - 512 >= 256 - MEMP_S2) mem_prompt_item(it - 512 - (256 - MEMP_S2), Z, MK, MV, BR, lds, tid, wave, lane);
                } } else if (it < 1280) { if (ITM & 8) {
                    const int i2 = it - 768, hm = i2 & 3, b = i2 >> 2;
                    LAS bf16* Ksm = (LAS bf16*)lds; LAS bf16* Vt = (LAS bf16*)(lds + 256 * 136 * 2);
#pragma unroll
                    for (int hb = 0; hb < 2; ++hb) { f32x4 kf[4][2], vf[4][2];
#pragma unroll
                        for (int i = 0; i < 4; ++i) { const int cid = tid + 512 * (4 * hb + i), key = cid >> 4, ch = cid & 15; const size_t so = ((((size_t)l * DBATCH + b) * NMEM + key) * 4 + hm) * 128 + ch * 8;
                            kf[i][0] = *(const f32x4*)(P.in[6] + so); kf[i][1] = *(const f32x4*)(P.in[6] + so + 4); vf[i][0] = *(const f32x4*)(P.in[7] + so); vf[i][1] = *(const f32x4*)(P.in[7] + so + 4); }
                        __builtin_amdgcn_sched_barrier(0);
#pragma unroll
                        for (int i = 0; i < 4; ++i) { const int cid = tid + 512 * (4 * hb + i), key = cid >> 4, ch = cid & 15; u32x4 kv, vv;
                            kv.x = pk2(kf[i][0].x, kf[i][0].y); kv.y = pk2(kf[i][0].z, kf[i][0].w); kv.z = pk2(kf[i][1].x, kf[i][1].y); kv.w = pk2(kf[i][1].z, kf[i][1].w);
                            vv.x = pk2(vf[i][0].x, vf[i][0].y); vv.y = pk2(vf[i][0].z, vf[i][0].w); vv.z = pk2(vf[i][1].x, vf[i][1].y); vv.w = pk2(vf[i][1].z, vf[i][1].w);
                            *(LAS u32x4*)(Ksm + key * 136 + ch * 8) = kv; vt_scatter<true>(Vt, 264, ch * 8, key, vv); }
                        __builtin_amdgcn_sched_barrier(0); }
                    __syncthreads();
                    if (wave == 0) { const int lq = lane & 15; const size_t row = (size_t)MP + b * 4 + (lq & 3);
                        mem_qtile(Ksm, Vt, Z + row * INW + MQO + hm * 128, BR + row * 1536 + 1024 + hm * 128, lq < 4, lane); }
                    __syncthreads();
                } } else if (it < 1296) { if (ITM & 16) {
                    const int wi = (it - 1280) * 8 + wave, g = wi & 31, b = wi >> 5;
                    const float l32r = LAMP[((size_t)(l * 32 + g) * 33 + 32) * 128 + lane * 2], l32i = LAMP[((size_t)(l * 32 + g) * 33 + 32) * 128 + lane * 2 + 1];
                    const float* ssp = SS + (size_t)(g * 512 + b * 128) * 128 + lane; bf16* hs = A2 + (size_t)(g * 512 + b * 128) * 640 + 512 + lane;
                    float hr = 0.f, hi = 0.f;
#pragma unroll 1
                    for (int j0 = 0; j0 < 128; j0 += 16) { float sr[16], si[16];
#pragma unroll
                        for (int j = 0; j < 16; ++j) { sr[j] = ssp[(size_t)(j0 + j) * 128]; si[j] = ssp[(size_t)(j0 + j) * 128 + 64]; }
                        __builtin_amdgcn_sched_barrier(0);
#pragma unroll
                        for (int j = 0; j < 16; ++j) { hs[(size_t)(j0 + j) * 640] = (bf16)f2bf(hr); hs[(size_t)(j0 + j) * 640 + 64] = (bf16)f2bf(hi);
                            const float nr = fmaf(l32r, hr, fmaf(-l32i, hi, sr[j])), ni = fmaf(l32r, hi, fmaf(l32i, hr, si[j])); hr = nr; hi = ni; }
                        __builtin_amdgcn_sched_barrier(0); }
                    const size_t oo = (((size_t)l * NB + b) * 32 + g) * 64 + lane; out[O_HRP + oo] = hr; out[O_HIP + oo] = hi;
                } } else { if (ITM & 16) {
                    const int wi = (it - 1296) * 8 + wave, g = wi & 31, b = wi >> 5; const size_t row0 = (size_t)MP + b * 4;
                    const int e = (l * 32 + g) * 64 + lane; const f32x4 lam = *(const f32x4*)((const float*)(ws + WS_LAM) + (size_t)e * 4);
                    const size_t so = (((size_t)l * DBATCH + b) * 32 + g) * 64 + lane; float hr = P.in[4][so], hi = P.in[5][so];
                    float br[16], bi[16], cr[16], ci[16];
                    { const f32x4* bp = (const f32x4*)((const float*)(ws + WS_BP) + (size_t)e * 32);
#pragma unroll
                      for (int q = 0; q < 4; ++q) { const f32x4 a = bp[q], b4 = bp[4 + q]; br[4 * q] = a.x; br[4 * q + 1] = a.y; br[4 * q + 2] = a.z; br[4 * q + 3] = a.w; bi[4 * q] = b4.x; bi[4 * q + 1] = b4.y; bi[4 * q + 2] = b4.z; bi[4 * q + 3] = b4.w; } }
                    { const float* cre = P.in[19] + ((size_t)(l * 32 + g) * 16) * 64 + lane; const float* cim = P.in[20] + ((size_t)(l * 32 + g) * 16) * 64 + lane;
#pragma unroll
                      for (int q = 0; q < 16; ++q) { cr[q] = cre[q * 64]; ci[q] = cim[q * 64]; } }
                    const float dcl = P.in[21][l * 512 + g * 16 + (lane >> 2)];
                    ssm_run<true, 4>(Z + row0 * INW + UO + g * 16, 4, lam.x, lam.y, br, bi, hr, hi, cr, ci, dcl, ZS + row0 * 512 + g * 16 + (lane >> 2), lane);
                    out[O_HRS + so] = hr; out[O_HIS + so] = hi;
                } }
              }
            }
        } else if constexpr (s == 3 && (PHM & 8)) {
            pg8::Gemm g{A2, (const bf16*)(ws + WS_BT2) + (size_t)l * 32 * 512 * 640, 16384, 16384, 640, 640, 640}; pg8::GroupOrder S{G, bid, 128, 1};
            pg8::EpiY E{A2, P.in[21] + l * 512, ZS}; pg8::gemm_phase<pg8::EpiY, pg8::GroupOrder, true, true>(lds, g, S, E);
            { pg8::Gemm g2{ZS, (const bf16*)(wb + OFF_WGLU), MT, 512, 512, 512, 512}; pg8::RangeOrder S2{G, bid - off128, 64, 2, 2};
              pg8::EpiGlu E2{ZS, BR}; pg8::gemm_phase<pg8::EpiGlu, pg8::RangeOrder, true, true>(lds, g2, S2, E2); }
            if (G == 256 && bid >= 256 - MEMP_S3) mem_prompt_item(MEMP_S2 + bid - (256 - MEMP_S3), Z, MK, MV, BR, lds, tid, wave, lane);
            else if (G != 256) { for (int i2 = MEMP_S2 + bid; i2 < MEMP_S2 + MEMP_S3; i2 += G) mem_prompt_item(i2, Z, MK, MV, BR, lds, tid, wave, lane); }
        } else if constexpr (s == 4 && (PHM & 16)) {
            { pg8::Gemm g{ZS, (const bf16*)(wb + OFF_WGLU), MP, 512, 512, 512, 512}; pg8::StaticOrder S; S.init(MP, 512, G, bid);
              pg8::EpiGlu E{ZS, BR}; pg8::gemm_phase<pg8::EpiGlu, pg8::StaticOrder, true, true>(lds, g, S, E); }
            { pg8::Gemm g{BR, (const bf16*)(wb + OFF_WBR), MT, DM, 512, 1536, 1536}; pg8::TailOrder S{bid - off128, 3, 1024, G};
              pg8::EpiGatePart E{Z, (float*)(ws + WS_PART)}; pg8::gemm_phase<pg8::EpiGatePart, pg8::TailOrder, true, true>(lds, g, S, E); }
            if (G == 256 && bid >= 256 - MEMP_S4) mem_prompt_item(MEMP_S2 + MEMP_S3 + bid - (256 - MEMP_S4), Z, MK, MV, BR, lds, tid, wave, lane);
            else if (G != 256) { for (int i2 = MEMP_S2 + MEMP_S3 + bid; i2 < 256; i2 += G) mem_prompt_item(i2, Z, MK, MV, BR, lds, tid, wave, lane); }
        } else if constexpr (s == 5 && (PHM & 32)) {
            pg8::Gemm g{BR, (const bf16*)(wb + OFF_WBR), MP, DM, 1536, 1536, 1536}; pg8::StaticOrder S; S.init(MP, DM, G, bid);
            pg8::EpiMerge E{Z, MERGED}; pg8::gemm_phase<pg8::EpiMerge, pg8::StaticOrder, true, true>(lds, g, S, E);
            for (int e = gt; e < MS * DM / 4; e += NGT) { const f32x4* pp = (const f32x4*)(ws + WS_PART) + e; const f32x4 v = pp[0] + pp[MS * DM / 4] + pp[2 * (MS * DM / 4)];
                u32x2 w; w.x = pk2(v.x, v.y); w.y = pk2(v.z, v.w); *(u32x2*)(MERGED + (size_t)MP * DM + (size_t)e * 4) = w; }
        } else if constexpr (s == 6 && (PHM & 64)) {
            { pg8::Gemm g{MERGED, (const bf16*)(wb + OFF_WOUT), MP, DM, DM, DM, DM}; pg8::StaticOrder S; S.init(MP, DM, G, bid);
              pg8::EpiRes E{l == 0 ? P.in[0] : X, l == 0 ? P.in[1] : X + (size_t)MP * DM, X, DM}; pg8::gemm_phase<pg8::EpiRes, pg8::StaticOrder, true, true>(lds, g, S, E); }
            { pg8::Gemm g{MERGED, (const bf16*)(wb + OFF_WOUT), MT, DM, 128, DM, DM}; pg8::TailOrder S{G - 1 - bid, 8, 256, G};
              pg8::EpiPart E{(float*)(ws + WS_PART), 256}; pg8::gemm_phase<pg8::EpiPart, pg8::TailOrder, true, true>(lds, g, S, E); }
        } else if constexpr ((s == 7 || s == 10) && (PHM & 128)) {
            constexpr bool last_ph = (ph == NPHASE - 1);
            for (int m = (last_ph ? MP + gw : gw); m < MT; m += NGW) { if (m < MP) rms_row_to_bf16(X + (size_t)m * DM, XN + (size_t)m * DM, lane);
                else rms_row_to_bf16(X + (size_t)m * DM, XN + (size_t)m * DM, lane, (const float*)(ws + WS_PART) + (size_t)(m - MP) * DM, s == 7 ? 8 : 11, X + (size_t)m * DM, !last_ph); }
        } else if constexpr (s == 8 && (PHM & 256)) {
            pg8::Gemm g{XN, (const bf16*)(wb + OFF_WUP), MT, 2 * DFF, DM, DM, DM}; pg8::StaticOrder S; S.init(MT, 2 * DFF, G, bid);
            pg8::EpiSwiglu E{HB}; pg8::gemm_phase<pg8::EpiSwiglu, pg8::StaticOrder, true, true>(lds, g, S, E);
        } else if constexpr (s == 9 && (PHM & 512)) {
            { pg8::Gemm g{HB, (const bf16*)(wb + OFF_WDN), MP, DM, DFF, DFF, DFF}; pg8::StaticOrder S; S.init(MP, DM, G, bid);
              pg8::EpiRes E{X, X + (size_t)MP * DM, DRY ? (float*)(ws + WS_MERGED) : X, DM}; pg8::gemm_phase<pg8::EpiRes, pg8::StaticOrder, true, true>(lds, g, S, E); }
            { pg8::Gemm g{HB, (const bf16*)(wb + OFF_WDN), MT, DM, 256, DFF, DFF}; pg8::TailOrder S{G - 1 - bid, 11, 512, G};
              pg8::EpiPart E{(float*)(ws + WS_PART), 512}; pg8::gemm_phase<pg8::EpiPart, pg8::TailOrder, true, true>(lds, g, S, E); }
        }
    }
}

#define XB_TMO      128
#define XB_XCNT(j)  (256  + 64 * (j))
#define XB_XSUB(j)  (1280 + 64 * (j))
#define XB_XGEN(j)  (2304 + 64 * (j))
#define XB_TOP      3328
#define XB_TOPGEN   3392
#define XCD_BAR_WORDS 3456
#define XB_SPIN_CAP (1u << 18)
__device__ __forceinline__ unsigned xb_ld(unsigned* p)              { return __hip_atomic_load(p, __ATOMIC_RELAXED, __HIP_MEMORY_SCOPE_AGENT); }
__device__ __forceinline__ unsigned xb_add(unsigned* p, unsigned v) { return __hip_atomic_fetch_add(p, v, __ATOMIC_RELAXED, __HIP_MEMORY_SCOPE_AGENT); }
__device__ __forceinline__ unsigned xb_xcc_id() { return (unsigned)__builtin_amdgcn_s_getreg((3 << 11) | 20) & 0xFu; }
#define XB_SPIN(cond, bar) do { unsigned _sp = 0; while (cond) { __builtin_amdgcn_s_sleep(1); \
    if ((++_sp & 255u) == 0u) { if (xb_ld(&(bar)[XB_TMO])) break; if (_sp > XB_SPIN_CAP) { atomicAdd(&(bar)[XB_TMO], 1u); break; } } } } while (0)
struct XcdBarrier { unsigned* bar; unsigned x; volatile LAS unsigned* st; };
__device__ __forceinline__ XcdBarrier xcd_barrier_post(unsigned* bar, volatile LAS unsigned* st) {
    XcdBarrier b; b.bar = bar; b.x = xb_xcc_id(); b.st = st;
    if (threadIdx.x == 0) (void)xb_add(&bar[XB_XCNT(b.x)], 1u);
    return b;
}
__device__ __forceinline__ void xcd_barrier_complete(unsigned* bar, unsigned x, unsigned& nloc, unsigned& nx) {
    const unsigned G = gridDim.x * gridDim.y * gridDim.z;
    unsigned sum, cnt, mine, sp = 0u;
    for (;;) {
        sum = 0u; cnt = 0u; mine = 0u;
#pragma unroll
        for (unsigned j = 0; j < 16; ++j) { const unsigned c = xb_ld(&bar[XB_XCNT(j)]); sum += c; cnt += (c > 0u) ? 1u : 0u; mine = (j == x) ? c : mine; }
        if (sum == G) break;
        __builtin_amdgcn_s_sleep(1);
        if ((++sp & 255u) == 0u) { if (xb_ld(&bar[XB_TMO])) break; if (sp > XB_SPIN_CAP) { atomicAdd(&bar[XB_TMO], 1u); break; } }
    }
    nloc = mine > 0u ? mine : 1u; nx = cnt > 0u ? cnt : 1u;
}
__device__ __forceinline__ void xcd_barrier(const XcdBarrier& b) {
    asm volatile("s_waitcnt vmcnt(0)" ::: "memory");
    __syncthreads();
    if (threadIdx.x == 0) {
        unsigned* bar = b.bar;
        __builtin_amdgcn_s_waitcnt(0);
        unsigned nloc = b.st[0], nx = b.st[1];
        if (nloc == 0u) { xcd_barrier_complete(bar, b.x, nloc, nx); b.st[0] = nloc; b.st[1] = nx; }
        const unsigned old = xb_add(&bar[XB_XSUB(b.x)], 1u);
        const unsigned gen = old / nloc;
        if (old + 1u == (gen + 1u) * nloc) {
            __builtin_amdgcn_fence(__ATOMIC_RELEASE, "agent");
            asm volatile("s_waitcnt vmcnt(0)" ::: "memory");
            const unsigned og = xb_add(&bar[XB_TOP], 1u);
            const unsigned tg = og / nx;
            if (og + 1u == (tg + 1u) * nx) xb_add(&bar[XB_TOPGEN], 1u);
            else XB_SPIN(xb_ld(&bar[XB_TOPGEN]) == tg, bar);
            __builtin_amdgcn_fence(__ATOMIC_ACQUIRE, "agent");
            xb_add(&bar[XB_XGEN(b.x)], 1u);
            asm volatile("s_waitcnt vmcnt(0)" ::: "memory");
        } else {
            XB_SPIN(xb_ld(&bar[XB_XGEN(b.x)]) == gen, bar);
            __builtin_amdgcn_fence(__ATOMIC_ACQUIRE, "agent");
            asm volatile("s_waitcnt vmcnt(0)" ::: "memory");
        }
    }
    __syncthreads();
}
constexpr int LDS_BAR_OFF = 147456 - 64;

__global__ void __launch_bounds__(512, 2) fwd_kernel(Params P) {
    extern __shared__ __attribute__((aligned(16))) unsigned char lds_raw[];
    LAS unsigned char* lds = (LAS unsigned char*)lds_raw;
    volatile LAS unsigned* bst = (volatile LAS unsigned*)(lds + LDS_BAR_OFF);
    if (threadIdx.x < 2) bst[threadIdx.x] = 0u;
    __syncthreads();
    XcdBarrier xbar; xbar.bar = (unsigned*)P.ws; xbar.x = 0; xbar.st = bst;
    if (P.ph_hi - P.ph_lo > 1) xbar = xcd_barrier_post((unsigned*)P.ws, bst);
    if (P.ph_hi < 0) cg::this_grid().sync();
#define RUNPH(I) if (P.ph_lo <= (I) && (I) < P.ph_hi) { if ((I) > P.ph_lo) xcd_barrier(xbar); run_phase<(I)>(P, lds); }
    RUNPH(0) RUNPH(1) RUNPH(2) RUNPH(3) RUNPH(4) RUNPH(5) RUNPH(6) RUNPH(7) RUNPH(8) RUNPH(9)
    RUNPH(10) RUNPH(11) RUNPH(12) RUNPH(13) RUNPH(14) RUNPH(15) RUNPH(16) RUNPH(17) RUNPH(18) RUNPH(19)
    RUNPH(20) RUNPH(21) RUNPH(22)
    static_assert(NPHASE == 23, "phase list");
#undef RUNPH
}

extern "C" void kernel_launch(void* const* d_in, const int* in_sizes, int n_in, void* d_out, int out_size, void* d_ws, size_t ws_size, hipStream_t stream) {
    static int grid = 0;
    if (grid == 0) {
        if (n_in != 32 || out_size != (int)O_END || ws_size < WS_END) { fprintf(stderr, "kernel_launch: unexpected shapes: n_in %d out %d ws %zu\n", n_in, out_size, ws_size); grid = -1; return; }
        int dev = 0, cus = 0, per_cu = 0;
        hipGetDevice(&dev); hipDeviceGetAttribute(&cus, hipDeviceAttributeMultiprocessorCount, dev);
        if (hipFuncSetAttribute((const void*)fwd_kernel, hipFuncAttributeMaxDynamicSharedMemorySize, LDS_BYTES) != hipSuccess) { fprintf(stderr, "kernel_launch: hipFuncSetAttribute failed\n"); grid = -1; return; }
        if (hipOccupancyMaxActiveBlocksPerMultiprocessor(&per_cu, (const void*)fwd_kernel, 512, LDS_BYTES) != hipSuccess || per_cu < 1) { fprintf(stderr, "kernel_launch: occupancy query says %d\n", per_cu); per_cu = 1; }
        (void)hipGetLastError();
        grid = cus * 1;
        if (grid <= 0) grid = 256;
    }
    if (grid < 0) return;
    Params p{};
    for (int i = 0; i < 32; ++i) p.in[i] = (const float*)d_in[i];
    p.out = (float*)d_out; p.ws = (unsigned char*)d_ws;
#if ONE_LAUNCH
    p.ph_lo = 0; p.ph_hi = NPHASE;
    if (hipMemsetAsync(d_ws, 0, 16384, stream) != hipSuccess) { fprintf(stderr, "kernel_launch: memset of barrier words failed\n"); return; }
    void* args[] = {&p};
    hipError_t e = hipLaunchCooperativeKernel((const void*)fwd_kernel, dim3(grid), dim3(512), args, LDS_BYTES, stream);
    if (e != hipSuccess) fprintf(stderr, "cooperative launch failed: %s (grid %d)\n", hipGetErrorString(e), grid);
#else
    for (int ph = 0; ph < NPHASE; ++ph) { p.ph_lo = ph; p.ph_hi = ph + 1; hipLaunchKernelGGL(fwd_kernel, dim3(grid), dim3(512), LDS_BYTES, stream, p); }
#endif
}
```
